# Optimizing an MI355X kernel written in HIP

```python
import jax
import jax.numpy as jnp
from jax import lax
import numpy as np


D_MODEL = 2048
BATCH = 2
SEQ = 4096
DEPTH = 1

GRID_W = 64
CTX_LEN = 256
HEAD_DIM = 128
N_Q_HEADS = 16
N_KV_HEADS = 4
Q_PER_KV = N_Q_HEADS // N_KV_HEADS
ATTN_WIDTH = N_Q_HEADS * HEAD_DIM
KV_WIDTH = N_KV_HEADS * HEAD_DIM
N_FOURIER_GROUPS = 4
FOURIER_GROUP_DIM = 256
FOURIER_WIDTH = N_FOURIER_GROUPS * FOURIER_GROUP_DIM
N_BRANCHES = 2
Q_END = ATTN_WIDTH
K_END = Q_END + KV_WIDTH
V_END = K_END + KV_WIDTH
F_END = V_END + FOURIER_WIDTH
IN_WIDTH = F_END + N_BRANCHES * D_MODEL
D_FF = 4 * D_MODEL
N_MOD = 6
Q_BLOCK = 128
ROPE_THETA = 10000.0
ROPE_AXIS_PAIRS = HEAD_DIM // 4
EPS = 1e-6

kernel_name = 'hybrid_gqa_fnet_adaln_prefix_block'


def rmsnorm(x, g):
    xf = x.astype(jnp.float32)
    xf = xf * lax.rsqrt(jnp.mean(xf * xf, axis=-1, keepdims=True) + EPS)
    return (xf * g.astype(jnp.float32)).astype(x.dtype)


def modulate(h, shift, scale):
    return h * (1 + scale) + shift


def axial_rope_tables(rows):
    inv = 1.0 / (ROPE_THETA ** (jnp.arange(ROPE_AXIS_PAIRS, dtype=jnp.float32) / ROPE_AXIS_PAIRS))
    row_ang = jnp.arange(rows, dtype=jnp.float32)[:, None] * inv
    col_ang = jnp.arange(GRID_W, dtype=jnp.float32)[:, None] * inv
    ang = jnp.concatenate([
        jnp.broadcast_to(row_ang[:, None, :], (rows, GRID_W, ROPE_AXIS_PAIRS)),
        jnp.broadcast_to(col_ang[None, :, :], (rows, GRID_W, ROPE_AXIS_PAIRS))], axis=-1)
    ang = ang.reshape(rows * GRID_W, 2 * ROPE_AXIS_PAIRS)
    return jnp.cos(ang), jnp.sin(ang)


def apply_rope(x, cos, sin):
    xf = x.astype(jnp.float32).reshape(x.shape[:-1] + (HEAD_DIM // 2, 2))
    x1, x2 = xf[..., 0], xf[..., 1]
    c = cos[None, :, None, :]
    s = sin[None, :, None, :]
    out = jnp.stack([x1 * c - x2 * s, x1 * s + x2 * c], axis=-1)
    return out.reshape(x.shape).astype(x.dtype)


def heads(t, n_heads):
    return t.reshape(t.shape[0], t.shape[1], n_heads, HEAD_DIM)


def block_attention(q, k, v):
    b, n = q.shape[0], q.shape[1]
    nblk = n // Q_BLOCK
    qb = q.reshape(b, nblk, Q_BLOCK, N_KV_HEADS, Q_PER_KV, HEAD_DIM).transpose(1, 0, 2, 3, 4, 5)
    scale = HEAD_DIM ** -0.5

    def one_block(q_blk):
        s = jnp.einsum('bqhgd,bkhd->bhgqk', q_blk, k).astype(jnp.float32) * scale
        p = jax.nn.softmax(s, axis=-1).astype(v.dtype)
        return jnp.einsum('bhgqk,bkhd->bqhgd', p, v)

    o = lax.map(one_block, qb)
    return o.transpose(1, 0, 2, 3, 4, 5).reshape(b, n, ATTN_WIDTH)


def fourier_mix(u):
    b, n = u.shape[0], u.shape[1]
    ug = u.astype(jnp.float32).reshape(b, n, N_FOURIER_GROUPS, FOURIER_GROUP_DIM)
    f = jnp.fft.fft2(ug, axes=(1, 3), norm='ortho').real
    return f.reshape(b, n, FOURIER_WIDTH).astype(u.dtype)


def merge_branches(attn_o, four_in, gate_logits, w_attn_o, w_fourier, w_out):
    a = attn_o @ w_attn_o
    f = fourier_mix(four_in) @ w_fourier
    g_a, g_f = jnp.split(gate_logits, N_BRANCHES, axis=-1)
    return (jax.nn.sigmoid(g_a) * a + jax.nn.sigmoid(g_f) * f) @ w_out


def sq_relu_mlp(h, w1, w2):
    return jnp.square(jax.nn.relu(h @ w1)) @ w2


def setup_inputs(seed: int = 0) -> dict:
    key = jax.random.key(seed)
    ks = jax.random.split(key, 17)

    def nrm(k, shape, scale):
        return jax.random.normal(k, shape, dtype=jnp.float32) * scale

    return {
        'x': nrm(ks[0], (BATCH, SEQ, D_MODEL), 1.0),
        'c': nrm(ks[1], (BATCH, D_MODEL), 1.0),
        'ctx': nrm(ks[2], (BATCH, CTX_LEN, D_MODEL), 1.0),
        'c_ctx': nrm(ks[3], (D_MODEL,), 1.0),
        'w_ada': nrm(ks[4], (DEPTH, D_MODEL, N_MOD * D_MODEL), 0.5 * D_MODEL ** -0.5),
        'b_ada': nrm(ks[5], (DEPTH, N_MOD * D_MODEL), 0.02),
        'norm1_g': 1.0 + nrm(ks[6], (DEPTH, D_MODEL), 0.02),
        'w_in': nrm(ks[7], (DEPTH, D_MODEL, IN_WIDTH), D_MODEL ** -0.5),
        'q_norm_g': 1.0 + nrm(ks[8], (DEPTH, HEAD_DIM), 0.02),
        'k_norm_g': 1.0 + nrm(ks[9], (DEPTH, HEAD_DIM), 0.02),
        'w_attn_o': nrm(ks[10], (DEPTH, ATTN_WIDTH, D_MODEL), ATTN_WIDTH ** -0.5),
        'w_fourier': nrm(ks[11], (DEPTH, FOURIER_WIDTH, D_MODEL), FOURIER_WIDTH ** -0.5),
        'w_out': nrm(ks[12], (DEPTH, D_MODEL, D_MODEL), D_MODEL ** -0.5),
        'norm2_g': 1.0 + nrm(ks[13], (DEPTH, D_MODEL), 0.02),
        'w1': nrm(ks[14], (DEPTH, D_MODEL, D_FF), D_MODEL ** -0.5),
        'w2': nrm(ks[15], (DEPTH, D_FF, D_MODEL), D_FF ** -0.5),
        'final_norm_g': 1.0 + nrm(ks[16], (D_MODEL,), 0.02),
    }


def reference(x, c, ctx, c_ctx, w_ada, b_ada, norm1_g, w_in, q_norm_g, k_norm_g,
              w_attn_o, w_fourier, w_out, norm2_g, w1, w2, final_norm_g):
    n_lat = x.shape[1]
    ROWS = n_lat // GRID_W
    cos, sin = axial_rope_tables(ROWS)
    xc = ctx
    for l in range(DEPTH):
        need_ctx_out = l < DEPTH - 1
        w_in_l = w_in[l]
        mod = jax.nn.silu(c) @ w_ada[l] + b_ada[l]
        mod_c = jax.nn.silu(c_ctx) @ w_ada[l] + b_ada[l]
        sh1, sc1, g1, sh2, sc2, g2 = jnp.split(mod[:, None, :], N_MOD, axis=-1)
        csh1, csc1, cg1, csh2, csc2, cg2 = jnp.split(mod_c, N_MOD, axis=-1)

        h = modulate(rmsnorm(x, norm1_g[l]), sh1, sc1)
        hc = modulate(rmsnorm(xc, norm1_g[l]), csh1, csc1)
        p = h @ w_in_l
        q = apply_rope(rmsnorm(heads(p[..., :Q_END], N_Q_HEADS), q_norm_g[l]), cos, sin)
        k = apply_rope(rmsnorm(heads(p[..., Q_END:K_END], N_KV_HEADS), k_norm_g[l]), cos, sin)
        v = heads(p[..., K_END:V_END], N_KV_HEADS)
        kc = rmsnorm(heads(hc @ w_in_l[:, Q_END:K_END], N_KV_HEADS), k_norm_g[l])
        vc = heads(hc @ w_in_l[:, K_END:V_END], N_KV_HEADS)
        k_all = jnp.concatenate([k, kc], axis=1)
        v_all = jnp.concatenate([v, vc], axis=1)
        o = block_attention(q, k_all, v_all)
        y = merge_branches(o, p[..., V_END:F_END], p[..., F_END:], w_attn_o[l], w_fourier[l], w_out[l])

        if need_ctx_out:
            qc = rmsnorm(heads(hc @ w_in_l[:, :Q_END], N_Q_HEADS), q_norm_g[l])
            pcr = hc @ w_in_l[:, V_END:]
            oc = block_attention(qc, kc, vc)
            yc = merge_branches(oc, pcr[..., :FOURIER_WIDTH], pcr[..., FOURIER_WIDTH:],
                                w_attn_o[l], w_fourier[l], w_out[l])
            xc = xc + cg1 * yc
            hc2 = modulate(rmsnorm(xc, norm2_g[l]), csh2, csc2)
            xc = xc + cg2 * sq_relu_mlp(hc2, w1[l], w2[l])

        x = x + g1 * y
        h2 = modulate(rmsnorm(x, norm2_g[l]), sh2, sc2)
        x = x + g2 * sq_relu_mlp(h2, w1[l], w2[l])
    return rmsnorm(x, final_norm_g)
```

```cpp
#include <hip/hip_runtime.h>
#include <hip/hip_cooperative_groups.h>
#include <hip/hip_bf16.h>
#include <cstdio>
#include <cstdint>
namespace cg = cooperative_groups;

#ifndef MK_COOP
#define MK_COOP 1
#endif

#define LAS __attribute__((address_space(3)))
typedef unsigned short bf16_t;
typedef short bf16x8 __attribute__((ext_vector_type(8)));
typedef float f32x4 __attribute__((ext_vector_type(4)));
typedef float f32x2 __attribute__((ext_vector_type(2)));
typedef unsigned u32x4 __attribute__((ext_vector_type(4)));
typedef unsigned u32x2 __attribute__((ext_vector_type(2)));

constexpr int DM = 2048, NB = 2, SEQ = 4096, MTOK = NB * SEQ, CTXL = 256, NCTX = NB * CTXL;
constexpr int HD = 128, NQH = 16, NKVH = 4, KVW = 512, FW = 1024, INW = 8192, DFF = 8192, NMOD = 6;
constexpr int SKV = SEQ + CTXL;
constexpr float EPS = 1e-6f;

constexpr size_t MiB = 1u << 20;
constexpr size_t WS_MOD = 0;
constexpr size_t WS_BAR = 192 * 1024;
constexpr size_t WS_CSD = 256 * 1024;
constexpr size_t WS_KCRAW = 512 * 1024;
constexpr size_t WS_WIN = 1 * MiB;
constexpr size_t WS_WO = 33 * MiB;
constexpr size_t WS_WFG = 41 * MiB;
constexpr size_t WS_WOUT = 45 * MiB;
constexpr size_t WS_WFP = 53 * MiB;
constexpr size_t WS_CSN = 61 * MiB;
constexpr size_t WS_W1 = 61 * MiB;
constexpr size_t WS_W2 = 93 * MiB;
constexpr size_t WS_XN = 125 * MiB;
constexpr size_t WS_G = 159 * MiB;
constexpr size_t WS_Q = 223 * MiB;
constexpr size_t WS_O = 255 * MiB;
constexpr size_t WS_HB = 159 * MiB;
constexpr size_t WS_KRAW = 287 * MiB;
constexpr size_t WS_KALL = 295 * MiB;
constexpr size_t WS_VALL = 304 * MiB;
constexpr size_t WS_UT = 313 * MiB;
constexpr size_t WS_END = 329 * MiB;

constexpr int LDS_BYTES = 131072 + 1024;

__device__ __forceinline__ unsigned cvt_pk_bf16(float lo, float hi) { unsigned r; asm volatile("v_cvt_pk_bf16_f32 %0, %1, %2" : "=v"(r) : "v"(lo), "v"(hi)); return r; }
__device__ __forceinline__ float bf_lo(unsigned w) { return __uint_as_float(w << 16); }
__device__ __forceinline__ float bf_hi(unsigned w) { return __uint_as_float(w & 0xffff0000u); }
__device__ __forceinline__ float sigmoidf_(float v) { return 1.0f / (1.0f + __expf(-v)); }
__device__ __forceinline__ float wave_sum(float v) {
#pragma unroll
    for (int o = 1; o < 64; o <<= 1) v += __shfl_xor(v, o);
    return v;
}

__device__ __forceinline__ int lane_now() { int l; asm volatile("v_mbcnt_lo_u32_b32 %0, -1, 0\n\tv_mbcnt_hi_u32_b32 %0, -1, %0" : "=v"(l)); return l; }

namespace pg8 {
constexpr int BM = 256, BK = 64, HALF = 128, HTB = HALF * BK * 2, STAGE_BYTES = 8 * HTB, NXCD = 8, WGM = 8;
__host__ __device__ __forceinline__ int lds_byte(int r, int c) { const int st = (r >> 4) * 2 + (c >> 5), rr = r & 15, cc = c & 31, ob = rr * 64 + cc * 2; return st * 1024 + (ob ^ (((ob >> 9) & 1) << 5)); }
__host__ __device__ __forceinline__ void stage_rc(int b, int& R, int& C) { const int st = b / 1024, sb = b % 1024, swz = sb ^ (((sb >> 9) & 1) << 5); R = (st >> 1) * 16 + swz / 64; C = (st & 1) * 32 + (swz % 64) / 2; }
__host__ __device__ __forceinline__ int perm32(int rho) { const int n = rho >> 4, i = rho & 15; return 8 * (i >> 2) + 4 * n + (i & 3); }

struct Unit { int pm, pn, kind, aux; };

__device__ __forceinline__ void tile_map(int L, int nM, int nN, int& pm, int& pn) {
    const int nwg = nM * nN; int wgid = L;
    { const int q = nwg / NXCD, r = nwg % NXCD, xcd = wgid % NXCD, off = wgid / NXCD; wgid = (xcd < r ? xcd * (q + 1) : r * (q + 1) + (xcd - r) * q) + off; }
    const int nig = WGM * nN, gid = wgid / nig, fm = gid * WGM, gsz = (nM - fm) < WGM ? (nM - fm) : WGM;
    pm = fm + ((wgid % nig) % gsz); pn = (wgid % nig) / gsz;
}

template <class Epi, class Sched, class Prob>
__device__ __forceinline__ void gemm_phase(LAS unsigned char* lds, const int wid, const int K, const Sched& S, const Prob& P, const Epi& E) {
    const int lane = lane_now(), tid = wid * 64 + lane, wr = wid >> 2, wc = wid & 3;
    const int nt = K / BK;
    unsigned voffA[2], voffB[2];
#pragma unroll
    for (int i = 0; i < 2; ++i) { int R, C; stage_rc(tid * 16 + i * 8192, R, C); const int Rb = (R & ~31) + perm32(R & 31);
        voffA[i] = (unsigned)(R * K + C) * 2u; voffB[i] = (unsigned)(Rb * K + C) * 2u; }
    const size_t kstep = (size_t)(BK * 2);
    const size_t hstep = (size_t)HALF * K * 2;
    const unsigned ldsw = (unsigned)wid * 1024u;
    const int aoff = lds_byte(wr * 64 + (lane & 15), (lane >> 4) * 8), boff = lds_byte(wc * 32 + (lane & 15), (lane >> 4) * 8);
#define PG8_SA(b, h) (((b) * 2 + (h)) * HTB)
#define PG8_SB(b, h) ((4 + (b) * 2 + (h)) * HTB)
#define PG8_STAGE(bufoff, gbase, voff) do { _Pragma("unroll") for (int _i = 0; _i < 2; ++_i) \
        __builtin_amdgcn_global_load_lds((const unsigned*)((const char*)(gbase) + (voff)[_i]), (LAS unsigned*)(lds + (bufoff) + ldsw + _i * 8192), 16, 0, 0); } while (0)
#define PG8_LDA(dst, b, h) do { _Pragma("unroll") for (int m = 0; m < 4; ++m) _Pragma("unroll") for (int k = 0; k < 2; ++k) dst[m][k] = *(const LAS bf16x8*)(lds + PG8_SA(b, h) + aoff + m * 2048 + k * 1024); } while (0)
#define PG8_LDB(dst, b, h) do { _Pragma("unroll") for (int n = 0; n < 2; ++n) _Pragma("unroll") for (int k = 0; k < 2; ++k) dst[n][k] = *(const LAS bf16x8*)(lds + PG8_SB(b, h) + boff + n * 2048 + k * 1024); } while (0)
#define PG8_MMA(ai, bj, At, Bt) do { __builtin_amdgcn_s_setprio(1); _Pragma("unroll") for (int m = 0; m < 4; ++m) _Pragma("unroll") for (int n = 0; n < 2; ++n) _Pragma("unroll") for (int k = 0; k < 2; ++k) \
        acc[ai][bj][m][n] = __builtin_amdgcn_mfma_f32_16x16x32_bf16(Bt[n][k], At[m][k], acc[ai][bj][m][n], 0, 0, 0); __builtin_amdgcn_s_setprio(0); } while (0)
#define PG8_WAIT_V(n) asm volatile("s_waitcnt vmcnt(" #n ")" ::: "memory")
#define PG8_WAIT_L(n) asm volatile("s_waitcnt lgkmcnt(" #n ")" ::: "memory")
#define PG8_BAR __builtin_amdgcn_s_barrier()
#define PG8_SCHED __builtin_amdgcn_sched_barrier(0)
    Unit cur, nxt; int ui = 0;
    if (!S.next(0, cur)) return;
    f32x4 acc[2][2][4][2];
#pragma unroll
    for (int a = 0; a < 2; ++a)
#pragma unroll
        for (int b = 0; b < 2; ++b)
#pragma unroll
            for (int m = 0; m < 4; ++m)
#pragma unroll
                for (int n = 0; n < 2; ++n) acc[a][b][m][n] = (f32x4){0.f, 0.f, 0.f, 0.f};
    bf16x8 At[4][2], B0[2][2], B1[2][2];
    const char* cA = P.A(cur); const char* cB = P.B(cur);
    PG8_STAGE(PG8_SB(0, 0), cB, voffB); PG8_STAGE(PG8_SB(0, 1), cB + hstep, voffB); PG8_STAGE(PG8_SA(0, 0), cA, voffA); PG8_STAGE(PG8_SA(0, 1), cA + hstep, voffA);
    if (wr == 1) PG8_BAR;
    PG8_WAIT_V(2); PG8_BAR;
    PG8_STAGE(PG8_SB(1, 0), cB + kstep, voffB); PG8_STAGE(PG8_SA(1, 0), cA + kstep, voffA); PG8_STAGE(PG8_SB(1, 1), cB + hstep + kstep, voffB);
    PG8_WAIT_V(6); PG8_BAR;
    for (;;) {
        const bool has_next = S.next(ui + 1, nxt);
        const char* nA = has_next ? P.A(nxt) : cA; const char* nB = has_next ? P.B(nxt) : cB;
        for (int t = 0; t < nt; t += 2) {
            const bool last = (t == nt - 2);
            const char* a1 = cA + (size_t)(t + 1) * kstep;
            const char* a2 = last ? nA : cA + (size_t)(t + 2) * kstep; const char* b2 = last ? nB : cB + (size_t)(t + 2) * kstep;
            const char* a3 = a2 + kstep; const char* b3 = b2 + kstep;
            PG8_LDB(B0, 0, 0); PG8_LDB(B1, 0, 1); PG8_SCHED; PG8_LDA(At, 0, 0); PG8_STAGE(PG8_SA(1, 1), a1 + hstep, voffA);
            PG8_WAIT_V(8); PG8_WAIT_L(0); PG8_BAR; PG8_MMA(0, 0, At, B0); PG8_MMA(0, 1, At, B1); PG8_BAR; PG8_SCHED;
            PG8_LDA(At, 0, 1); PG8_STAGE(PG8_SB(0, 0), b2, voffB); PG8_STAGE(PG8_SB(0, 1), b2 + hstep, voffB); PG8_STAGE(PG8_SA(0, 0), a2, voffA);
            PG8_WAIT_V(8); PG8_WAIT_L(0); PG8_BAR; PG8_MMA(1, 0, At, B0); PG8_MMA(1, 1, At, B1); PG8_BAR; PG8_SCHED;
            PG8_LDB(B0, 1, 0); PG8_LDB(B1, 1, 1); PG8_SCHED; PG8_LDA(At, 1, 0); PG8_STAGE(PG8_SA(0, 1), a2 + hstep, voffA);
            PG8_WAIT_V(8); PG8_WAIT_L(0); PG8_BAR; PG8_MMA(0, 0, At, B0); PG8_MMA(0, 1, At, B1); PG8_BAR; PG8_SCHED;
            PG8_LDA(At, 1, 1); PG8_STAGE(PG8_SB(1, 0), b3, voffB); PG8_STAGE(PG8_SB(1, 1), b3 + hstep, voffB); PG8_STAGE(PG8_SA(1, 0), a3, voffA);
            PG8_WAIT_V(8); PG8_WAIT_L(0); PG8_BAR; PG8_MMA(1, 0, At, B0); PG8_MMA(1, 1, At, B1); PG8_BAR; PG8_SCHED;
        }
        if (wr == 0) PG8_BAR;
        { const int l2 = lane_now(); E(acc, cur, wr, wc, l2 & 15, l2 >> 4); }
        if (!has_next) break;
#pragma unroll
        for (int a = 0; a < 2; ++a)
#pragma unroll
            for (int b = 0; b < 2; ++b)
#pragma unroll
                for (int m = 0; m < 4; ++m)
#pragma unroll
                    for (int n = 0; n < 2; ++n) acc[a][b][m][n] = (f32x4){0.f, 0.f, 0.f, 0.f};
        cur = nxt; cA = nA; cB = nB; ++ui;
        if (wr == 1) PG8_BAR;
    }
    PG8_WAIT_V(0);
    PG8_BAR;
#undef PG8_SA
#undef PG8_SB
#undef PG8_STAGE
#undef PG8_LDA
#undef PG8_LDB
#undef PG8_MMA
#undef PG8_WAIT_V
#undef PG8_WAIT_L
#undef PG8_BAR
#undef PG8_SCHED
}

__device__ __forceinline__ void store_tile_bf16(const f32x4 (&acc)[2][2][4][2], bf16_t* dst, size_t pitch, float sc, int wr, int wc, int fr, int fq) {
    asm volatile("" : "+v"(fr), "+v"(fq));
    const unsigned lo = (unsigned)(wr * 64 + fr) * (unsigned)pitch + (unsigned)(wc * 32 + 8 * fq);
#pragma unroll
    for (int ai = 0; ai < 2; ++ai)
#pragma unroll
        for (int m = 0; m < 4; ++m) { bf16_t* rowu = dst + (size_t)(ai * HALF + m * 16) * pitch;
#pragma unroll
            for (int bj = 0; bj < 2; ++bj) { const f32x4 v0 = acc[ai][bj][m][0] * sc, v1 = acc[ai][bj][m][1] * sc;
                u32x4 w; w.x = cvt_pk_bf16(v0[0], v0[1]); w.y = cvt_pk_bf16(v0[2], v0[3]); w.z = cvt_pk_bf16(v1[0], v1[1]); w.w = cvt_pk_bf16(v1[2], v1[3]);
                *(u32x4*)(rowu + bj * HALF + lo) = w; } }
}
}

namespace att {
using bf16 = __hip_bfloat16;
constexpr int D = 128, NW = 8, QBLK = 32, KVBLK = 64;
constexpr float SCALE = 0.088388347648318440f;
constexpr float THR = 8.f;
constexpr int LDQ = DM, LDK = KVW, LDO = DM;
constexpr size_t SHM_V = KVBLK * D * 2, SHM_K = KVBLK * D * 2, SHM_ATTN = 2 * SHM_V + 2 * SHM_K + NW * 64 * 4;
using s16x4 = __attribute__((ext_vector_type(4))) short;
using f32x16 = __attribute__((ext_vector_type(16))) float;
#define KSWZ(row, colB) ((row) * 256 + ((colB) ^ (((row) & 7) << 4)))
#define SBAR() __builtin_amdgcn_sched_barrier(0)
__device__ __forceinline__ int crow(int r, int hi) { return (r & 3) + 8 * (r >> 2) + 4 * hi; }
__device__ __forceinline__ unsigned cvtpk(float lo, float hi) { unsigned r; asm volatile("v_cvt_pk_bf16_f32 %0, %1, %2" : "=v"(r) : "v"(lo), "v"(hi)); return r; }
__device__ __forceinline__ void partialSM(f32x16& p0, f32x16& p1, float& m_reg, float& mn, float& alpha) {
  constexpr float C = SCALE * 1.4426950408889634f;
  float pmax = p0[0]; for (int r = 1; r < 16; ++r) pmax = fmaxf(pmax, p0[r]); for (int r = 0; r < 16; ++r) pmax = fmaxf(pmax, p1[r]);
  { auto rr = __builtin_amdgcn_permlane32_swap(__float_as_uint(pmax), __float_as_uint(pmax), false, false);
    pmax = fmaxf(__uint_as_float(rr[0]), __uint_as_float(rr[1])); }
  if (__builtin_expect(__all(pmax - m_reg <= THR / SCALE), 1)) { mn = m_reg; alpha = 1.f; }
  else { mn = fmaxf(m_reg, pmax); alpha = __builtin_amdgcn_exp2f((m_reg - mn) * C); m_reg = mn; }
  float mnC = -mn * C;
  for (int r = 0; r < 16; ++r) p0[r] = fmaf(p0[r], C, mnC); for (int r = 0; r < 16; ++r) p1[r] = fmaf(p1[r], C, mnC);
  for (int r = 0; r < 16; ++r) p0[r] = __builtin_amdgcn_exp2f(p0[r]);
}
__device__ __forceinline__ void finishSM(f32x16& p0, f32x16& p1, float alpha, float& l_reg, bf16x8& pa0, bf16x8& pa1, bf16x8& pa2, bf16x8& pa3) {
  for (int r = 0; r < 16; ++r) p1[r] = __builtin_amdgcn_exp2f(p1[r]);
  float ps = 0; for (int r = 0; r < 16; ++r) ps += p0[r]; for (int r = 0; r < 16; ++r) ps += p1[r];
  { auto rr = __builtin_amdgcn_permlane32_swap(__float_as_uint(ps), __float_as_uint(ps), false, false);
    ps = __uint_as_float(rr[0]) + __uint_as_float(rr[1]); }
  l_reg = l_reg * alpha + ps;
#define PK4(P, BASE, OUT) do { unsigned a0 = cvtpk(P[BASE + 0], P[BASE + 1]), a1 = cvtpk(P[BASE + 2], P[BASE + 3]);   \
    unsigned b0 = cvtpk(P[BASE + 4], P[BASE + 5]), b1 = cvtpk(P[BASE + 6], P[BASE + 7]);                              \
    auto r0 = __builtin_amdgcn_permlane32_swap(a0, b0, false, false); auto r1 = __builtin_amdgcn_permlane32_swap(a1, b1, false, false); \
    u32x4 w = {r0[0], r1[0], r0[1], r1[1]}; OUT = *reinterpret_cast<bf16x8*>(&w); } while (0)
  PK4(p0, 0, pa0); PK4(p0, 8, pa1); PK4(p1, 0, pa2); PK4(p1, 8, pa3);
#undef PK4
}
__device__ __forceinline__ void qkt(f32x16& p0, f32x16& p1, const bf16* Ks, const bf16x8* qr, int r32, int hi) {
  p0 = f32x16{}; p1 = f32x16{};
  for (int d0 = 0; d0 < 8; ++d0) { int cb = (d0 * 16 + hi * 8) * 2;
    bf16x8 b0 = *reinterpret_cast<const bf16x8*>((const char*)Ks + KSWZ(r32, cb));
    bf16x8 b1 = *reinterpret_cast<const bf16x8*>((const char*)Ks + KSWZ(32 + r32, cb));
    p0 = __builtin_amdgcn_mfma_f32_32x32x16_bf16(b0, qr[d0], p0, 0, 0, 0);
    p1 = __builtin_amdgcn_mfma_f32_32x32x16_bf16(b1, qr[d0], p1, 0, 0, 0); }
}
__device__ __forceinline__ int v_st(int k, int c) { const int kk = (k & ~0xC) | ((k & 4) << 1) | ((k & 8) >> 1); return ((kk >> 3) * 4 + (c >> 5)) * 512 + ((kk & 7) * 32 + (c & 31)) * 2; }
__device__ __forceinline__ int v_rd_base(int lane) { return ((lane & 3) << 3) | (((lane >> 2) & 3) << 6) | (((lane >> 4) & 1) << 5) | (((lane >> 5) & 1) << 8); }
constexpr int v_rd_off(int d0, int ks, int half) { return d0 * 512 + ks * 4096 + half * 2048; }
template <int OFF> __device__ __forceinline__ s16x4 tr_read(int vb) {
  s16x4 r; asm volatile("ds_read_b64_tr_b16 %0, %1 offset:%2" : "=&v"(r) : "v"(vb), "i"(OFF) : "memory"); return r;
}
template <int D0> __device__ __forceinline__ void pv_one(f32x16& od, int vb, bf16x8 pa0, bf16x8 pa1, bf16x8 pa2, bf16x8 pa3) {
  const s16x4 l0 = tr_read<v_rd_off(D0, 0, 0)>(vb), h0 = tr_read<v_rd_off(D0, 0, 1)>(vb), l1 = tr_read<v_rd_off(D0, 1, 0)>(vb), h1 = tr_read<v_rd_off(D0, 1, 1)>(vb);
  const s16x4 l2 = tr_read<v_rd_off(D0, 2, 0)>(vb), h2 = tr_read<v_rd_off(D0, 2, 1)>(vb), l3 = tr_read<v_rd_off(D0, 3, 0)>(vb), h3 = tr_read<v_rd_off(D0, 3, 1)>(vb);
  asm volatile("s_waitcnt lgkmcnt(0)" ::: "memory"); SBAR();
#define PK(L, H) (bf16x8){L[0], L[1], L[2], L[3], H[0], H[1], H[2], H[3]}
  od = __builtin_amdgcn_mfma_f32_32x32x16_bf16(pa0, PK(l0, h0), od, 0, 0, 0);
  od = __builtin_amdgcn_mfma_f32_32x32x16_bf16(pa1, PK(l1, h1), od, 0, 0, 0);
  od = __builtin_amdgcn_mfma_f32_32x32x16_bf16(pa2, PK(l2, h2), od, 0, 0, 0);
  od = __builtin_amdgcn_mfma_f32_32x32x16_bf16(pa3, PK(l3, h3), od, 0, 0, 0);
#undef PK
}
__device__ __forceinline__ void pv_d0(f32x16* o, int vb, bf16x8 pa0, bf16x8 pa1, bf16x8 pa2, bf16x8 pa3) {
  pv_one<0>(o[0], vb, pa0, pa1, pa2, pa3); pv_one<1>(o[1], vb, pa0, pa1, pa2, pa3); pv_one<2>(o[2], vb, pa0, pa1, pa2, pa3); pv_one<3>(o[3], vb, pa0, pa1, pa2, pa3);
}

__device__ __forceinline__ void attn_dense_body(const bf16* __restrict__ Qb, const bf16* __restrict__ Kh, const bf16* __restrict__ Vh,
                                                bf16* __restrict__ Ob, int seq, char* lds, const int wid) {
  const int lane = lane_now(), tid = wid * 64 + lane, r32 = lane & 31, hi = lane >> 5;
  bf16* V_lds = (bf16*)lds; bf16* K_lds = (bf16*)(lds + 2 * SHM_V);
  float* ws = (float*)(lds + 2 * SHM_V + 2 * SHM_K) + wid * 64; float* li_l = ws; float* al_l = ws + 32;
  float m_reg = -1e30f, l_reg = 0; f32x16 o[4] = {}; bf16x8 qr[8];
  const bf16* Qw = Qb + (long)(wid * QBLK + r32) * LDQ + hi * 8;
#pragma unroll
  for (int d0 = 0; d0 < 8; ++d0) qr[d0] = *reinterpret_cast<const bf16x8*>(Qw + d0 * 16);
  const int sr = tid >> 4, sc = (tid & 15) * 8, vst0 = v_st(sr, sc), vst1 = v_st(32 + sr, sc);
  const int vb0 = (int)(uintptr_t)V_lds + v_rd_base(lane);
  struct { bf16x8 vs0, vs1, ks0, ks1; } sr_[2];
#define SLOAD(i, k0) do { sr_[i].vs0 = *reinterpret_cast<const bf16x8*>(&Vh[(long)((k0) + sr) * LDK + sc]); sr_[i].vs1 = *reinterpret_cast<const bf16x8*>(&Vh[(long)((k0) + 32 + sr) * LDK + sc]); \
    sr_[i].ks0 = *reinterpret_cast<const bf16x8*>(&Kh[(long)((k0) + sr) * LDK + sc]); sr_[i].ks1 = *reinterpret_cast<const bf16x8*>(&Kh[(long)((k0) + 32 + sr) * LDK + sc]); } while (0)
#define SWRITE(b, i) do { *(bf16x8*)((char*)V_lds + (b) * SHM_V + vst0) = sr_[i].vs0;          \
    *(bf16x8*)((char*)V_lds + (b) * SHM_V + vst1) = sr_[i].vs1; int kc = sc * 2;               \
    *(bf16x8*)((char*)K_lds + (b) * SHM_K + KSWZ(sr, kc)) = sr_[i].ks0;                       \
    *(bf16x8*)((char*)K_lds + (b) * SHM_K + KSWZ(32 + sr, kc)) = sr_[i].ks1; } while (0)
#define SWAIT() asm volatile("s_waitcnt vmcnt(4)" ::: "memory")
#define RESC(a) do { if (__any((a) < 1.f)) { if (hi == 0) al_l[r32] = (a); asm volatile("s_waitcnt lgkmcnt(0)" ::: "memory"); \
    for (int d = 0; d < 4; ++d) for (int r = 0; r < 16; ++r) o[d][r] *= al_l[crow(r, hi)]; } } while (0)
  f32x16 pA0, pA1, pB0, pB1; float mnA, mnB, alA, alB; bf16x8 pa0, pa1, pa2, pa3; const int NT = seq / KVBLK;
  constexpr int SE = 0, SO = 1;
  SLOAD(SE, 0); asm volatile("s_waitcnt vmcnt(0)" ::: "memory"); SWRITE(0, SE); __syncthreads();
  qkt(pA0, pA1, K_lds, qr, r32, hi); partialSM(pA0, pA1, m_reg, mnA, alA);
  SLOAD(SO, KVBLK); if (2 < NT) SLOAD(SE, 2 * KVBLK);
  SWAIT(); SWRITE(1, SO); __syncthreads();
  for (int j = 1; j + 1 < NT; j += 2) {
    SBAR(); qkt(pB0, pB1, (bf16*)((char*)K_lds + SHM_K), qr, r32, hi);
    finishSM(pA0, pA1, alA, l_reg, pa0, pa1, pa2, pa3); SBAR();
    SLOAD(SO, (j + 2) * KVBLK); SBAR();
    pv_d0(o, vb0, pa0, pa1, pa2, pa3); partialSM(pB0, pB1, m_reg, mnB, alB);
    __syncthreads(); SWAIT(); SWRITE(0, SE);
    RESC(alB); __syncthreads();
    SBAR(); qkt(pA0, pA1, K_lds, qr, r32, hi);
    finishSM(pB0, pB1, alB, l_reg, pa0, pa1, pa2, pa3); SBAR();
    if (j + 3 < NT) SLOAD(SE, (j + 3) * KVBLK); SBAR();
    pv_d0(o, vb0 + (int)SHM_V, pa0, pa1, pa2, pa3); partialSM(pA0, pA1, m_reg, mnA, alA);
    __syncthreads(); SWAIT(); SWRITE(1, SO);
    RESC(alA); __syncthreads();
  }
  SBAR(); qkt(pB0, pB1, (bf16*)((char*)K_lds + SHM_K), qr, r32, hi);
  finishSM(pA0, pA1, alA, l_reg, pa0, pa1, pa2, pa3); SBAR();
  pv_d0(o, vb0, pa0, pa1, pa2, pa3); partialSM(pB0, pB1, m_reg, mnB, alB);
  __syncthreads(); RESC(alB);
  finishSM(pB0, pB1, alB, l_reg, pa0, pa1, pa2, pa3); SBAR();
  pv_d0(o, vb0 + (int)SHM_V, pa0, pa1, pa2, pa3);
  if (hi == 0) li_l[r32] = l_reg; asm volatile("s_waitcnt lgkmcnt(0)" ::: "memory");
  float rli[16];
#pragma unroll
  for (int r = 0; r < 16; ++r) rli[r] = __builtin_amdgcn_rcpf(li_l[crow(r, hi)]);
  bf16* Ow = Ob + (long)(wid * QBLK) * LDO;
#pragma unroll
  for (int r = 0; r < 16; ++r) { int orow = crow(r, hi);
    for (int d0 = 0; d0 < 4; ++d0) Ow[(long)orow * LDO + d0 * 32 + r32] = __float2bfloat16(o[d0][r] * rli[r]); }
  __syncthreads();
#undef SLOAD
#undef SWRITE
#undef SWAIT
#undef RESC
}
#undef KSWZ
#undef SBAR
}

#define XB_TMO      128
#define XB_XCNT(j)  (256  + 64 * (j))
#define XB_XSUB(j)  (1280 + 64 * (j))
#define XB_XGEN(j)  (2304 + 64 * (j))
#define XB_TOP      3328
#define XB_TOPGEN   3392
#define XCD_BAR_WORDS 3456
#define XB_SPIN_CAP (1u << 18)
__device__ __forceinline__ unsigned xb_ld(unsigned* p)              { return __hip_atomic_load(p, __ATOMIC_RELAXED, __HIP_MEMORY_SCOPE_AGENT); }
__device__ __forceinline__ unsigned xb_add(unsigned* p, unsigned v) { return __hip_atomic_fetch_add(p, v, __ATOMIC_RELAXED, __HIP_MEMORY_SCOPE_AGENT); }
__device__ __forceinline__ unsigned xb_xcc_id() { return (unsigned)__builtin_amdgcn_s_getreg((3 << 11) | 20) & 0xFu; }
#define XB_SPIN(cond, bar) do { unsigned _sp = 0; while (cond) { __builtin_amdgcn_s_sleep(1); \
    if ((++_sp & 255u) == 0u) { if (xb_ld(&(bar)[XB_TMO])) break; if (_sp > XB_SPIN_CAP) { atomicAdd(&(bar)[XB_TMO], 1u); break; } } } } while (0)
struct XcdBarrier { unsigned* bar; unsigned x; volatile LAS unsigned* st; };
__device__ __forceinline__ XcdBarrier xcd_barrier_post(unsigned* bar, volatile LAS unsigned* st, int wave) {
    XcdBarrier b; b.bar = bar; b.x = xb_xcc_id(); b.st = st;
    if (wave == 0 && lane_now() == 0) (void)xb_add(&bar[XB_XCNT(b.x)], 1u);
    return b;
}
__device__ __forceinline__ void xcd_barrier_complete(unsigned* bar, unsigned x, unsigned& nloc, unsigned& nx) {
    const unsigned G = gridDim.x * gridDim.y * gridDim.z;
    unsigned sum, cnt, mine, sp = 0u;
    for (;;) {
        sum = 0u; cnt = 0u; mine = 0u;
#pragma unroll
        for (unsigned j = 0; j < 16; ++j) { const unsigned c = xb_ld(&bar[XB_XCNT(j)]); sum += c; cnt += (c > 0u) ? 1u : 0u; mine = (j == x) ? c : mine; }
        if (sum == G) break;
        __builtin_amdgcn_s_sleep(1);
        if ((++sp & 255u) == 0u) { if (xb_ld(&bar[XB_TMO])) break; if (sp > XB_SPIN_CAP) { atomicAdd(&bar[XB_TMO], 1u); break; } }
    }
    nloc = mine > 0u ? mine : 1u; nx = cnt > 0u ? cnt : 1u;
}
__device__ __forceinline__ void xcd_barrier(const XcdBarrier& b, int wave) {
    asm volatile("s_waitcnt vmcnt(0)" ::: "memory");
    __syncthreads();
    if (wave == 0 && lane_now() == 0) {
        unsigned* bar = b.bar;
        __builtin_amdgcn_s_waitcnt(0);
        unsigned nloc = b.st[0], nx = b.st[1];
        if (nloc == 0u) { xcd_barrier_complete(bar, b.x, nloc, nx); b.st[0] = nloc; b.st[1] = nx; }
        const unsigned old = xb_add(&bar[XB_XSUB(b.x)], 1u);
        const unsigned gen = old / nloc;
        if (old + 1u == (gen + 1u) * nloc) {
            __builtin_amdgcn_fence(__ATOMIC_RELEASE, "agent");
            asm volatile("s_waitcnt vmcnt(0)" ::: "memory");
            const unsigned og = xb_add(&bar[XB_TOP], 1u);
            const unsigned tg = og / nx;
            if (og + 1u == (tg + 1u) * nx) xb_add(&bar[XB_TOPGEN], 1u);
            else XB_SPIN(xb_ld(&bar[XB_TOPGEN]) == tg, bar);
            __builtin_amdgcn_fence(__ATOMIC_ACQUIRE, "agent");
            xb_add(&bar[XB_XGEN(b.x)], 1u);
            asm volatile("s_waitcnt vmcnt(0)" ::: "memory");
        } else {
            XB_SPIN(xb_ld(&bar[XB_XGEN(b.x)]) == gen, bar);
            __builtin_amdgcn_fence(__ATOMIC_ACQUIRE, "agent");
            asm volatile("s_waitcnt vmcnt(0)" ::: "memory");
        }
    }
    __syncthreads();
}

struct Args { const float* in[17]; float* out; unsigned char* ws; int ph_lo, ph_hi; };
enum { I_X = 0, I_C, I_CTX, I_CCTX, I_WADA, I_BADA, I_N1G, I_WIN, I_QNG, I_KNG, I_WAO, I_WF, I_WOUT, I_N2G, I_W1, I_W2, I_FNG };

struct Frame {
    LAS unsigned char* lds;
    int wave, G, bid;
};

__device__ __forceinline__ void transpose_item(const float* W, int ldw, int k0, int n0, bf16_t* dst, int dpitch, LAS float* scr, int lane) {
#pragma unroll 8
    for (int i = 0; i < 32; ++i) { const int kk = 2 * i + (lane >> 5); scr[kk * 33 + (lane & 31)] = W[(size_t)(k0 + kk) * ldw + n0 + (lane & 31)]; }
    asm volatile("s_waitcnt lgkmcnt(0)" ::: "memory");
    const int c = lane & 7;
#pragma unroll
    for (int j = 0; j < 4; ++j) { const int n = (lane >> 3) + 8 * j; const LAS float* s = scr + (8 * c) * 33 + n;
        u32x4 o; o.x = cvt_pk_bf16(s[0 * 33], s[1 * 33]); o.y = cvt_pk_bf16(s[2 * 33], s[3 * 33]); o.z = cvt_pk_bf16(s[4 * 33], s[5 * 33]); o.w = cvt_pk_bf16(s[6 * 33], s[7 * 33]);
        *(u32x4*)(dst + (size_t)n * dpitch + 8 * c) = o; }
    asm volatile("s_waitcnt lgkmcnt(0)" ::: "memory");
}

__device__ __forceinline__ void norm_mod_rows(const float* src, bf16_t* dst, const float* gam, const float* sc, const float* sh, int r0, int cnt, int lane) {
    f32x4 A[8], Bv[8];
#pragma unroll
    for (int j = 0; j < 8; ++j) { const int c = 4 * lane + 256 * j; const f32x4 g = *(const f32x4*)(gam + c); const f32x4 s = *(const f32x4*)(sc + c); A[j] = g * (s + 1.0f); Bv[j] = *(const f32x4*)(sh + c); }
    for (int r = r0; r < r0 + cnt; ++r) {
        const f32x4* xr = (const f32x4*)(src + (size_t)r * DM) + lane;
        f32x4 v[8]; float ss = 0.f;
#pragma unroll
        for (int j = 0; j < 8; ++j) { v[j] = xr[64 * j]; ss += (v[j].x * v[j].x + v[j].y * v[j].y) + (v[j].z * v[j].z + v[j].w * v[j].w); }
        const float rstd = 1.0f / sqrtf(wave_sum(ss) * (1.0f / DM) + EPS);
        u32x2* o8 = (u32x2*)(dst + (size_t)r * DM) + lane;
#pragma unroll
        for (int j = 0; j < 8; ++j) { const f32x4 y = v[j] * rstd * A[j] + Bv[j]; u32x2 w; w.x = cvt_pk_bf16(y.x, y.y); w.y = cvt_pk_bf16(y.z, y.w); o8[64 * j] = w; }
    }
}

using pg8::Unit;
struct SchedWfp { int G, c; __device__ bool next(int i, Unit& u) const { const int L = i * G + c; if (L >= 64) return false; u.aux = L >> 4; const int l = L & 15; u.pm = l & 7; u.pn = l >> 3; u.kind = 0; return true; } };
struct ProbWfp { const char* wfg; const char* csd; __device__ const char* A(const Unit& u) const { return wfg + (size_t)u.aux * 2048 * 256 * 2 + (size_t)u.pm * 256 * 256 * 2; } __device__ const char* B(const Unit& u) const { return csd + (size_t)u.pn * 256 * 256 * 2; } };
struct EpiWfp { bf16_t* wfp; __device__ void operator()(const f32x4 (&acc)[2][2][4][2], const Unit& u, int wr, int wc, int fr, int fq) const {
    pg8::store_tile_bf16(acc, wfp + (size_t)(u.pm * 256) * 2048 + u.aux * 512 + u.pn * 256, 2048, 1.0f, wr, wc, fr, fq); } };

struct SchedIn { int G, c; __device__ bool next(int i, Unit& u) const { const int L = i * G + c; if (L >= 1032) return false; u.aux = 0;
    if (L < 896) { u.kind = 0; pg8::tile_map(L, 32, 28, u.pm, u.pn); } else if (L < 1024) { u.kind = 1; pg8::tile_map(L - 896, 4, 32, u.pm, u.pn); } else { u.kind = 2; const int l = L - 1024; u.pm = 32 + (l >> 2); u.pn = 8 + (l & 3); } return true; } };
struct ProbIn { const char* xn; const char* win; static constexpr size_t TS = (size_t)256 * 2048 * 2;
    __device__ const char* A(const Unit& u) const { return (u.kind == 1 ? win + (size_t)7168 * 2048 * 2 : xn) + (size_t)u.pm * TS; }
    __device__ const char* B(const Unit& u) const { return (u.kind == 1 ? xn : win) + (size_t)u.pn * TS; } };
struct EpiIn { bf16_t *q, *kraw, *kcraw, *vall, *g, *ut;
    __device__ void operator()(const f32x4 (&acc)[2][2][4][2], const Unit& u, int wr, int wc, int fr, int fq) const {
        bf16_t* dst; size_t pitch;
        if (u.kind == 1) { dst = ut + (size_t)(u.pn >> 4) * 1024 * 4096 + (size_t)(u.pm * 256) * 4096 + (u.pn & 15) * 256; pitch = 4096; }
        else if (u.pn < 8) { dst = q + (size_t)(u.pm * 256) * 2048 + u.pn * 256; pitch = 2048; }
        else if (u.pn < 10) { dst = (u.kind == 0 ? kraw + (size_t)(u.pm * 256) * 512 : kcraw + (size_t)((u.pm - 32) * 256) * 512) + (u.pn - 8) * 256; pitch = 512; }
        else if (u.pn < 12) { const size_t row = (u.kind == 0) ? (size_t)(u.pm * 256 + (u.pm >> 4) * CTXL) : (size_t)((u.pm - 32) * SKV + SEQ); dst = vall + row * 512 + (u.pn - 10) * 256; pitch = 512; }
        else { dst = g + (size_t)(u.pm * 256) * 4096 + (u.pn - 12) * 256; pitch = 4096; }
        pg8::store_tile_bf16(acc, dst, pitch, 1.0f, wr, wc, fr, fq); } };

struct SchedDft { int G, c; __device__ bool next(int i, Unit& u) const { const int L = i * G + c; if (L >= 256) return false; u.aux = L >> 7; u.kind = 0; pg8::tile_map(L & 127, 32, 4, u.pm, u.pn); return true; } };
struct ProbDft { const char* csn; const char* ut; static constexpr size_t TS = (size_t)256 * 4096 * 2;
    __device__ const char* A(const Unit& u) const { return csn + (size_t)u.pm * TS; }
    __device__ const char* B(const Unit& u) const { return ut + (size_t)u.aux * 1024 * 4096 * 2 + (size_t)u.pn * TS; } };
struct EpiDft { bf16_t* zcat; __device__ void operator()(const f32x4 (&acc)[2][2][4][2], const Unit& u, int wr, int wc, int fr, int fq) const {
    pg8::store_tile_bf16(acc, zcat + (size_t)(u.aux * SEQ + (u.pm & 15) * 256) * 2048 + u.pn * 512 + (u.pm >> 4) * 256, 2048, 1.0f / 1024.0f, wr, wc, fr, fq); } };

struct SchedMerge { int G, c; __device__ bool next(int i, Unit& u) const { const int t = (i >> 1) * G + c; if (t >= 256) return false; u.kind = i & 1; u.aux = 0; pg8::tile_map(t, 32, 8, u.pm, u.pn); return true; } };
struct ProbMerge { const char *o, *zcat, *wo, *wfp; static constexpr size_t TS = (size_t)256 * 2048 * 2;
    __device__ const char* A(const Unit& u) const { return (u.kind ? zcat : o) + (size_t)u.pm * TS; }
    __device__ const char* B(const Unit& u) const { return (u.kind ? wfp : wo) + (size_t)u.pn * TS; } };
struct EpiMerge { const bf16_t* g; float* t1; bf16_t* t;
    __device__ void operator()(const f32x4 (&acc)[2][2][4][2], const Unit& u, int wr, int wc, int fr, int fq) const {
        asm volatile("" : "+v"(fr), "+v"(fq));
        const unsigned lrow = (unsigned)(wr * 64 + fr), lcol = (unsigned)(wc * 32 + 8 * fq);
        const unsigned lo_g = lrow * 4096u + lcol, lo_t = lrow * 2048u + lcol;
        const bf16_t* gu = g + (size_t)(u.pm * 256) * 4096 + (u.kind ? 2048 : 0) + u.pn * 256;
        float* t1u = t1 + (size_t)(u.pm * 256) * 2048 + u.pn * 256; bf16_t* tu = t + (size_t)(u.pm * 256) * 2048 + u.pn * 256;
#pragma unroll
        for (int ai = 0; ai < 2; ++ai)
#pragma unroll
            for (int m = 0; m < 4; ++m) {
#pragma unroll
                for (int bj = 0; bj < 2; ++bj) { const size_t ro = (size_t)(ai * 128 + m * 16);
                    const u32x4 gw = *(const u32x4*)(gu + ro * 4096 + bj * 128 + lo_g);
                    f32x4 v0 = acc[ai][bj][m][0], v1 = acc[ai][bj][m][1];
                    v0.x *= sigmoidf_(bf_lo(gw.x)); v0.y *= sigmoidf_(bf_hi(gw.x)); v0.z *= sigmoidf_(bf_lo(gw.y)); v0.w *= sigmoidf_(bf_hi(gw.y));
                    v1.x *= sigmoidf_(bf_lo(gw.z)); v1.y *= sigmoidf_(bf_hi(gw.z)); v1.z *= sigmoidf_(bf_lo(gw.w)); v1.w *= sigmoidf_(bf_hi(gw.w));
                    float* tp = t1u + ro * 2048 + bj * 128 + lo_t;
                    if (u.kind == 0) { *(f32x4*)tp = v0; *(f32x4*)(tp + 4) = v1; }
                    else { v0 += *(const f32x4*)tp; v1 += *(const f32x4*)(tp + 4);
                        u32x4 w; w.x = cvt_pk_bf16(v0[0], v0[1]); w.y = cvt_pk_bf16(v0[2], v0[3]); w.z = cvt_pk_bf16(v1[0], v1[1]); w.w = cvt_pk_bf16(v1[2], v1[3]);
                        *(u32x4*)(tu + ro * 2048 + bj * 128 + lo_t) = w; } } }
    } };

struct SchedN8 { int G, c; __device__ bool next(int i, Unit& u) const { const int L = i * G + c; if (L >= 256) return false; u.kind = 0; u.aux = 0; pg8::tile_map(L, 32, 8, u.pm, u.pn); return true; } };
struct ProbPlain { const char* a; const char* b; size_t ts; __device__ const char* A(const Unit& u) const { return a + (size_t)u.pm * ts; } __device__ const char* B(const Unit& u) const { return b + (size_t)u.pn * ts; } };
struct EpiRes { const float* res; float* out; const float* gate;
    __device__ void operator()(const f32x4 (&acc)[2][2][4][2], const Unit& u, int wr, int wc, int fr, int fq) const {
        asm volatile("" : "+v"(fr), "+v"(fq));
        const unsigned lcol = (unsigned)(wc * 32 + 8 * fq), lo = (unsigned)(wr * 64 + fr) * 2048u + lcol;
        const float* gb = gate + (size_t)(u.pm >> 4) * (NMOD * DM) + u.pn * 256;
        const float* ru = res + (size_t)(u.pm * 256) * 2048 + u.pn * 256; float* ou = out + (size_t)(u.pm * 256) * 2048 + u.pn * 256;
#pragma unroll
        for (int bj = 0; bj < 2; ++bj) { const f32x4 g0 = *(const f32x4*)(gb + bj * 128 + lcol), g1 = *(const f32x4*)(gb + bj * 128 + lcol + 4);
#pragma unroll
            for (int ai = 0; ai < 2; ++ai)
#pragma unroll
                for (int m = 0; m < 4; ++m) { const size_t ro = (size_t)(ai * 128 + m * 16) * 2048 + bj * 128;
                    const f32x4 r0 = *(const f32x4*)(ru + ro + lo), r1 = *(const f32x4*)(ru + ro + lo + 4);
                    *(f32x4*)(ou + ro + lo) = r0 + g0 * acc[ai][bj][m][0]; *(f32x4*)(ou + ro + lo + 4) = r1 + g1 * acc[ai][bj][m][1]; } }
    } };

struct SchedUp { int G, c; __device__ bool next(int i, Unit& u) const { const int L = i * G + c; if (L >= 1024) return false; u.kind = 0; u.aux = 0; pg8::tile_map(L, 32, 32, u.pm, u.pn); return true; } };
struct EpiUp { bf16_t* hb;
    __device__ void operator()(const f32x4 (&acc)[2][2][4][2], const Unit& u, int wr, int wc, int fr, int fq) const {
        asm volatile("" : "+v"(fr), "+v"(fq));
        const unsigned lo = (unsigned)(wr * 64 + fr) * (unsigned)DFF + (unsigned)(wc * 32 + 8 * fq);
        bf16_t* hu = hb + (size_t)(u.pm * 256) * DFF + u.pn * 256;
#pragma unroll
        for (int ai = 0; ai < 2; ++ai)
#pragma unroll
            for (int m = 0; m < 4; ++m) {
#pragma unroll
                for (int bj = 0; bj < 2; ++bj) { f32x4 v0 = acc[ai][bj][m][0], v1 = acc[ai][bj][m][1];
                    v0.x = fmaxf(v0.x, 0.f); v0.y = fmaxf(v0.y, 0.f); v0.z = fmaxf(v0.z, 0.f); v0.w = fmaxf(v0.w, 0.f); v1.x = fmaxf(v1.x, 0.f); v1.y = fmaxf(v1.y, 0.f); v1.z = fmaxf(v1.z, 0.f); v1.w = fmaxf(v1.w, 0.f);
                    v0 = v0 * v0; v1 = v1 * v1;
                    u32x4 w; w.x = cvt_pk_bf16(v0[0], v0[1]); w.y = cvt_pk_bf16(v0[2], v0[3]); w.z = cvt_pk_bf16(v1[0], v1[1]); w.w = cvt_pk_bf16(v1[2], v1[3]);
                    *(u32x4*)(hu + (size_t)(ai * 128 + m * 16) * DFF + bj * 128 + lo) = w; } }
    } };

constexpr int N_PHASES = 11;

template <bool COOP>
__global__ void __launch_bounds__(512, 2) fwd_kernel(Args args) {
    extern __shared__ __attribute__((aligned(16))) unsigned char lds_raw[];
    Frame F;
    F.lds = (LAS unsigned char*)lds_raw;
    F.wave = __builtin_amdgcn_readfirstlane(threadIdx.x >> 6);
    F.G = gridDim.x; F.bid = blockIdx.x;
    unsigned char* ws = args.ws;
    const int lo = args.ph_lo, hi = args.ph_hi;
    const int gw = F.bid * 8 + F.wave, NGW = F.G * 8;
    const int NGT = F.G * 512;
#define PHASE_IDS() const int lane_ = lane_now(), tid_ = F.wave * 64 + lane_, gt = F.bid * 512 + tid_; (void)gt

    float* mod = (float*)(ws + WS_MOD);
    bf16_t* csd = (bf16_t*)(ws + WS_CSD); bf16_t* kcraw = (bf16_t*)(ws + WS_KCRAW);
    bf16_t* winT = (bf16_t*)(ws + WS_WIN); bf16_t* woT = (bf16_t*)(ws + WS_WO); bf16_t* wfg = (bf16_t*)(ws + WS_WFG); bf16_t* woutT = (bf16_t*)(ws + WS_WOUT);
    bf16_t* wfpT = (bf16_t*)(ws + WS_WFP); bf16_t* csn = (bf16_t*)(ws + WS_CSN); bf16_t* w1T = (bf16_t*)(ws + WS_W1); bf16_t* w2T = (bf16_t*)(ws + WS_W2);
    bf16_t* xn = (bf16_t*)(ws + WS_XN); bf16_t* gbuf = (bf16_t*)(ws + WS_G); bf16_t* qb = (bf16_t*)(ws + WS_Q); bf16_t* ob = (bf16_t*)(ws + WS_O);
    bf16_t* hb = (bf16_t*)(ws + WS_HB); bf16_t* kraw = (bf16_t*)(ws + WS_KRAW); bf16_t* kall = (bf16_t*)(ws + WS_KALL); bf16_t* vall = (bf16_t*)(ws + WS_VALL); bf16_t* ut = (bf16_t*)(ws + WS_UT);
    bf16_t* zcat = xn; bf16_t* tb = qb; float* t1 = args.out;

#define IN(k) (lo <= (k) && (k) < hi)
#define SEAM(k) do { if (COOP) { if (IN(k) && IN((k) + 1)) { xcd_barrier(bar, F.wave); } } } while (0)

    volatile LAS unsigned* MISC = (volatile LAS unsigned*)(F.lds + 131072);
    { PHASE_IDS(); if (tid_ < 64) MISC[tid_] = 0u;
    if (COOP && F.bid == 0) { unsigned* bw = (unsigned*)(ws + WS_BAR); for (int i = tid_; i < XCD_BAR_WORDS; i += 512) bw[i] = 0u; } }
    __syncthreads();
    if (IN(0)) { PHASE_IDS();
        {
            LAS float* sv = (LAS float*)(F.lds + 69632);
            LAS float* red = (LAS float*)(F.lds + 94208);
            for (int i = tid_; i < 3 * DM; i += 512) { const float v = (i < 2 * DM) ? args.in[I_C][i] : args.in[I_CCTX][i - 2 * DM]; sv[i] = v / (1.0f + __expf(-v)); }
            __syncthreads();
            const float* wada = args.in[I_WADA];
            for (int cgp = F.bid; cgp < 256; cgp += F.G) {
                const int col = cgp * 48 + (lane_ < 48 ? lane_ : 47);
                float a0 = 0.f, a1 = 0.f, a2 = 0.f;
                const int kb = F.wave * 256;
#pragma unroll 16
                for (int k = 0; k < 256; ++k) { const float w = wada[(size_t)(kb + k) * (NMOD * DM) + col]; a0 += sv[kb + k] * w; a1 += sv[DM + kb + k] * w; a2 += sv[2 * DM + kb + k] * w; }
                if (lane_ < 48) { red[(F.wave * 3 + 0) * 48 + lane_] = a0; red[(F.wave * 3 + 1) * 48 + lane_] = a1; red[(F.wave * 3 + 2) * 48 + lane_] = a2; }
                __syncthreads();
                if (tid_ < 144) { const int j = tid_ / 48, l = tid_ % 48; float s = 0.f;
#pragma unroll
                    for (int w = 0; w < 8; ++w) s += red[(w * 3 + j) * 48 + l];
                    mod[j * (NMOD * DM) + cgp * 48 + l] = s + args.in[I_BADA][cgp * 48 + l]; }
                __syncthreads();
            }
        }
        {
            LAS float* scr = (LAS float*)(F.lds + F.wave * 8448);
            constexpr int I_IN = 32 * 256, I_AO = 32 * 64, I_FO = 16 * 64, I_OUT = 32 * 64, NIT = I_IN + I_AO + I_FO + I_OUT;
            for (int it = gw; it < NIT; it += NGW) {
                int r = it;
                if (r < I_IN) { const int kb = r >> 8, nb = r & 255, n0 = nb * 32; const int drow = n0 < 3072 ? n0 : (n0 < 4096 ? n0 + 4096 : n0 - 1024);
                    transpose_item(args.in[I_WIN], INW, kb * 64, n0, winT + (size_t)drow * DM + kb * 64, DM, scr, lane_); continue; } r -= I_IN;
                if (r < I_AO) { const int kb = r >> 6, nb = r & 63; transpose_item(args.in[I_WAO], DM, kb * 64, nb * 32, woT + (size_t)(nb * 32) * DM + kb * 64, DM, scr, lane_); continue; } r -= I_AO;
                if (r < I_FO) { const int kb = r >> 6, nb = r & 63, k0 = kb * 64, g = k0 >> 8; transpose_item(args.in[I_WF], DM, k0, nb * 32, wfg + ((size_t)g * 2048 + nb * 32) * 256 + (k0 & 255), 256, scr, lane_); continue; } r -= I_FO;
                { const int kb = r >> 6, nb = r & 63; transpose_item(args.in[I_WOUT], DM, kb * 64, nb * 32, woutT + (size_t)(nb * 32) * DM + kb * 64, DM, scr, lane_); }
            }
        }
        for (int it = gt; it < 8192 * 512; it += NGT) { const int R = it >> 9, n0 = (it & 511) * 8, k = R & 4095, ri = R >> 12;
            unsigned w[4];
#pragma unroll
            for (int e = 0; e < 4; ++e) { float v[2];
#pragma unroll
                for (int h = 0; h < 2; ++h) { const int mm = (k * (n0 + 2 * e + h)) & 4095; const float rev = (float)mm * (1.0f / 4096.0f); v[h] = ri ? -__builtin_amdgcn_sinf(rev) : __builtin_amdgcn_cosf(rev); }
                w[e] = cvt_pk_bf16(v[0], v[1]); }
            *(u32x4*)(csn + (size_t)R * 4096 + n0) = (u32x4){w[0], w[1], w[2], w[3]}; }
        for (int it = gt; it < 512 * 32; it += NGT) { const int R = it >> 5, n0 = (it & 31) * 8, k = R & 255, ri = R >> 8;
            unsigned w[4];
#pragma unroll
            for (int e = 0; e < 4; ++e) { float v[2];
#pragma unroll
                for (int h = 0; h < 2; ++h) { const int mm = (k * (n0 + 2 * e + h)) & 255; const float rev = (float)mm * (1.0f / 256.0f); v[h] = ri ? __builtin_amdgcn_sinf(rev) : __builtin_amdgcn_cosf(rev); }
                w[e] = cvt_pk_bf16(v[0], v[1]); }
            *(u32x4*)(csd + (size_t)R * 256 + n0) = (u32x4){w[0], w[1], w[2], w[3]}; }
        __syncthreads();
    }
    XcdBarrier bar; bar.bar = (unsigned*)(ws + WS_BAR); bar.x = 0; bar.st = MISC + 8;
    if (COOP) { cg::this_grid().sync();
        bar = xcd_barrier_post((unsigned*)(ws + WS_BAR), MISC + 8, F.wave); }

    if (IN(1)) { PHASE_IDS();
        {
            for (int it = gw; it < 2048 + 128; it += NGW) {
                if (it < 2048) { const int r0 = it * 4, b = r0 / SEQ; const float* mb = mod + (size_t)b * (NMOD * DM);
                    norm_mod_rows(args.in[I_X], xn, args.in[I_N1G], mb + DM, mb, r0, 4, lane_); }
                else { const int r0 = (it - 2048) * 4; const float* mb = mod + (size_t)2 * (NMOD * DM);
                    norm_mod_rows(args.in[I_CTX], xn + (size_t)MTOK * DM, args.in[I_N1G], mb + DM, mb, r0, 4, lane_); }
            }
        }
        __syncthreads();
        { SchedWfp S{F.G, F.bid}; ProbWfp P{(const char*)wfg, (const char*)csd}; EpiWfp E{wfpT};
          pg8::gemm_phase<EpiWfp, SchedWfp, ProbWfp>(F.lds, F.wave, 256, S, P, E); }
    }
    SEAM(1);

    if (IN(2)) {
        SchedIn S{F.G, F.bid}; ProbIn P{(const char*)xn, (const char*)winT}; EpiIn E{qb, kraw, kcraw, vall, gbuf, ut};
        pg8::gemm_phase<EpiIn, SchedIn, ProbIn>(F.lds, F.wave, 2048, S, P, E);
    }
    SEAM(2);

    if (IN(3)) { PHASE_IDS();
        LAS f32x2* tab = (LAS f32x2*)F.lds;
        for (int i = tid_; i < 2048; i += 512) { const int idx = i >> 5, j = i & 31; const float inv = __builtin_amdgcn_exp2f(-(float)j * (13.287712379549449f / 32.0f));
            const float ang = (float)idx * inv, rev = ang * 0.15915494309189535f; tab[i] = (f32x2){__builtin_amdgcn_cosf(rev), __builtin_amdgcn_sinf(rev)}; }
        __syncthreads();
        const int l16 = lane_ & 15, sub = lane_ >> 4;
        const f32x4 gq0 = *(const f32x4*)(args.in[I_QNG] + 8 * l16), gq1 = *(const f32x4*)(args.in[I_QNG] + 8 * l16 + 4);
        const f32x4 gk0 = *(const f32x4*)(args.in[I_KNG] + 8 * l16), gk1 = *(const f32x4*)(args.in[I_KNG] + 8 * l16 + 4);
        constexpr int NRQ = MTOK * NQH, NRK = MTOK * NKVH, NRC = NCTX * NKVH, NITEMS = (NRQ + NRK + NRC) / 4;
        for (int it = gw; it < NITEMS; it += NGW) {
            int row = it * 4 + sub; const bf16_t* src; bf16_t* dst; int pos = -1; bool isq = false;
            if (row < NRQ) { const int t = row >> 4, h = row & 15; src = qb + (size_t)t * DM + h * HD; dst = qb + (size_t)t * DM + h * HD; pos = t & (SEQ - 1); isq = true; }
            else if (row < NRQ + NRK) { row -= NRQ; const int t = row >> 2, h = row & 3; src = kraw + (size_t)t * KVW + h * HD; dst = kall + (size_t)(t + (t / SEQ) * CTXL) * KVW + h * HD; pos = t & (SEQ - 1); }
            else { row -= NRQ + NRK; const int t = row >> 2, h = row & 3; src = kcraw + (size_t)t * KVW + h * HD; dst = kall + (size_t)((t / CTXL) * SKV + SEQ + (t % CTXL)) * KVW + h * HD; }
            const u32x4 raw = *(const u32x4*)(src + 8 * l16);
            float v[8] = {bf_lo(raw.x), bf_hi(raw.x), bf_lo(raw.y), bf_hi(raw.y), bf_lo(raw.z), bf_hi(raw.z), bf_lo(raw.w), bf_hi(raw.w)};
            float ss = 0.f;
#pragma unroll
            for (int e = 0; e < 8; ++e) ss += v[e] * v[e];
            ss += __shfl_xor(ss, 1); ss += __shfl_xor(ss, 2); ss += __shfl_xor(ss, 4); ss += __shfl_xor(ss, 8);
            const float rstd = 1.0f / sqrtf(ss * (1.0f / HD) + EPS);
            const f32x4 g0 = isq ? gq0 : gk0, g1 = isq ? gq1 : gk1;
            v[0] *= rstd * g0.x; v[1] *= rstd * g0.y; v[2] *= rstd * g0.z; v[3] *= rstd * g0.w; v[4] *= rstd * g1.x; v[5] *= rstd * g1.y; v[6] *= rstd * g1.z; v[7] *= rstd * g1.w;
            if (pos >= 0) { const int idx = (l16 < 8) ? (pos >> 6) : (pos & 63); const int j0 = (4 * l16) & 31;
#pragma unroll
                for (int e = 0; e < 4; ++e) { const f32x2 cs = tab[idx * 32 + j0 + e]; const float x1 = v[2 * e], x2 = v[2 * e + 1]; v[2 * e] = x1 * cs.x - x2 * cs.y; v[2 * e + 1] = x1 * cs.y + x2 * cs.x; } }
            u32x4 w; w.x = cvt_pk_bf16(v[0], v[1]); w.y = cvt_pk_bf16(v[2], v[3]); w.z = cvt_pk_bf16(v[4], v[5]); w.w = cvt_pk_bf16(v[6], v[7]);
            *(u32x4*)(dst + 8 * l16) = w;
        }
        __syncthreads();
    }
    SEAM(3);

    if (IN(4)) {
        {
            const bool x8 = (F.G % 8) == 0; const int per = x8 ? F.G / 8 : F.G;
            for (int i = 0;; ++i) {
                int u;
                if (x8) { const int xcd = F.bid & 7, j = F.bid >> 3, idx = i * per + j; if (idx >= 64) break; u = xcd * 64 + idx; }
                else { u = i * F.G + F.bid; if (u >= 512) break; }
                const int bk = u >> 6, idx = u & 63, b = bk >> 2, kvh = bk & 3, h = kvh * 4 + (idx >> 4), qblk = idx & 15;
                const att::bf16* Qp = (const att::bf16*)qb + (size_t)(b * SEQ + qblk * 256) * DM + h * HD;
                const att::bf16* Kp = (const att::bf16*)kall + (size_t)(b * SKV) * KVW + kvh * HD;
                const att::bf16* Vp = (const att::bf16*)vall + (size_t)(b * SKV) * KVW + kvh * HD;
                att::bf16* Op = (att::bf16*)ob + (size_t)(b * SEQ + qblk * 256) * DM + h * HD;
                att::attn_dense_body(Qp, Kp, Vp, Op, SKV, (char*)lds_raw, F.wave);
            }
        }
        __syncthreads();
        { SchedDft S{F.G, F.bid}; ProbDft P{(const char*)csn, (const char*)ut}; EpiDft E{zcat};
          pg8::gemm_phase<EpiDft, SchedDft, ProbDft>(F.lds, F.wave, 4096, S, P, E); }
    }
    SEAM(4);

    if (IN(5)) {
        SchedMerge S{F.G, F.bid}; ProbMerge P{(const char*)ob, (const char*)zcat, (const char*)woT, (const char*)wfpT}; EpiMerge E{gbuf, t1, tb};
        pg8::gemm_phase<EpiMerge, SchedMerge, ProbMerge>(F.lds, F.wave, 2048, S, P, E);
    }
    SEAM(5);

    if (IN(6)) {
        SchedN8 S{F.G, F.bid}; ProbPlain P{(const char*)tb, (const char*)woutT, (size_t)256 * 2048 * 2}; EpiRes E{args.in[I_X], args.out, mod + 2 * DM};
        pg8::gemm_phase<EpiRes, SchedN8, ProbPlain>(F.lds, F.wave, 2048, S, P, E);
    }
    SEAM(6);

    if (IN(7)) { PHASE_IDS();
        for (int it = gw; it < 2048; it += NGW) { const int r0 = it * 4, b = r0 / SEQ; const float* mb = mod + (size_t)b * (NMOD * DM);
            norm_mod_rows(args.out, xn, args.in[I_N2G], mb + 4 * DM, mb + 3 * DM, r0, 4, lane_); }
        __syncthreads();
        LAS float* scr = (LAS float*)(F.lds + F.wave * 8448);
        constexpr int I_1 = 32 * 256, I_2 = 128 * 64;
        for (int it = gw; it < I_1 + I_2; it += NGW) {
            if (it < I_1) { const int kb = it >> 8, nb = it & 255; transpose_item(args.in[I_W1], DFF, kb * 64, nb * 32, w1T + (size_t)(nb * 32) * DM + kb * 64, DM, scr, lane_); }
            else { const int r = it - I_1, kb = r >> 6, nb = r & 63; transpose_item(args.in[I_W2], DM, kb * 64, nb * 32, w2T + (size_t)(nb * 32) * DFF + kb * 64, DFF, scr, lane_); }
        }
        __syncthreads();
    }
    SEAM(7);

    if (IN(8)) {
        SchedUp S{F.G, F.bid}; ProbPlain P{(const char*)xn, (const char*)w1T, (size_t)256 * 2048 * 2}; EpiUp E{hb};
        pg8::gemm_phase<EpiUp, SchedUp, ProbPlain>(F.lds, F.wave, 2048, S, P, E);
    }
    SEAM(8);

    if (IN(9)) {
        SchedN8 S{F.G, F.bid}; ProbPlain P{(const char*)hb, (const char*)w2T, (size_t)256 * 8192 * 2}; EpiRes E{args.out, args.out, mod + 5 * DM};
        pg8::gemm_phase<EpiRes, SchedN8, ProbPlain>(F.lds, F.wave, 8192, S, P, E);
    }
    SEAM(9);

    if (IN(10)) { PHASE_IDS();
        const float* fg = args.in[I_FNG];
        f32x4 A[8];
#pragma unroll
        for (int j = 0; j < 8; ++j) A[j] = *(const f32x4*)(fg + 4 * lane_ + 256 * j);
        for (int r = gw; r < MTOK; r += NGW) {
            f32x4* xr = (f32x4*)(args.out + (size_t)r * DM) + lane_;
            f32x4 v[8]; float ss = 0.f;
#pragma unroll
            for (int j = 0; j < 8; ++j) { v[j] = xr[64 * j]; ss += (v[j].x * v[j].x + v[j].y * v[j].y) + (v[j].z * v[j].z + v[j].w * v[j].w); }
            const float rstd = 1.0f / sqrtf(wave_sum(ss) * (1.0f / DM) + EPS);
#pragma unroll
            for (int j = 0; j < 8; ++j) xr[64 * j] = v[j] * rstd * A[j];
        }
    }
#undef IN
#undef SEAM
}

extern "C" void kernel_launch(void* const* d_in, const int* in_sizes, int n_in, void* d_out, int out_size, void* d_ws, size_t ws_size, hipStream_t stream) {
    static int grid = 0;
    if (grid == 0) {
        if (n_in != 17 || in_sizes[0] != MTOK * DM || out_size != MTOK * DM || ws_size < WS_END) {
            fprintf(stderr, "kernel_launch: shape/workspace mismatch: n_in %d in0 %d out %d ws %zu (need %zu)\n", n_in, n_in > 0 ? in_sizes[0] : -1, out_size, ws_size, (size_t)WS_END); grid = -1; return; }
        int dev = 0, cus = 0, per_cu = 0;
        hipGetDevice(&dev); hipDeviceGetAttribute(&cus, hipDeviceAttributeMultiprocessorCount, dev);
        if (hipFuncSetAttribute((const void*)fwd_kernel<true>, hipFuncAttributeMaxDynamicSharedMemorySize, LDS_BYTES) != hipSuccess) fprintf(stderr, "kernel_launch: hipFuncSetAttribute(coop) failed\n");
        if (hipFuncSetAttribute((const void*)fwd_kernel<false>, hipFuncAttributeMaxDynamicSharedMemorySize, LDS_BYTES) != hipSuccess) fprintf(stderr, "kernel_launch: hipFuncSetAttribute(plain) failed\n");
        if (hipOccupancyMaxActiveBlocksPerMultiprocessor(&per_cu, (const void*)fwd_kernel<true>, 512, LDS_BYTES) != hipSuccess || per_cu < 1) { fprintf(stderr, "kernel_launch: occupancy query says %d blocks per CU\n", per_cu); per_cu = 1; }
        (void)hipGetLastError();
        grid = cus;
        fprintf(stderr, "kernel_launch: grid %d (cus %d, per_cu %d)\n", grid, cus, per_cu);
    }
    if (grid < 0) return;
    Args a{};
    for (int i = 0; i < 17; ++i) a.in[i] = (const float*)d_in[i];
    a.out = (float*)d_out; a.ws = (unsigned char*)d_ws;
#if MK_COOP
    a.ph_lo = 0; a.ph_hi = N_PHASES;
    void* kargs[] = {&a};
    hipError_t e = hipLaunchCooperativeKernel((const void*)fwd_kernel<true>, dim3(grid), dim3(512), kargs, LDS_BYTES, stream);
    if (e != hipSuccess) fprintf(stderr, "kernel_launch: cooperative launch failed: %s (grid %d)\n", hipGetErrorString(e), grid);
#else
    for (int p = 0; p < N_PHASES; ++p) { a.ph_lo = p; a.ph_hi = p + 1; hipLaunchKernelGGL(fwd_kernel<false>, dim3(grid), dim3(512), LDS_BYTES, stream, a); }
    const hipError_t le = hipPeekAtLastError();
    if (le != hipSuccess) fprintf(stderr, "kernel_launch: launch failed: %s\n", hipGetErrorName(le));
#endif
}
```

```cpp
#include <hip/hip_runtime.h>
#include <hip/hip_cooperative_groups.h>
#include <hip/hip_bf16.h>
#include <cstdio>
#include <cstdint>
namespace cg = cooperative_groups;

#ifndef MK_COOP
#define MK_COOP 1
#endif

#define LAS __attribute__((address_space(3)))
typedef unsigned short bf16_t;
typedef short bf16x8 __attribute__((ext_vector_type(8)));
typedef float f32x4 __attribute__((ext_vector_type(4)));
typedef float f32x2 __attribute__((ext_vector_type(2)));
typedef unsigned u32x4 __attribute__((ext_vector_type(4)));
typedef unsigned u32x2 __attribute__((ext_vector_type(2)));

constexpr int DM = 2048, NB = 2, SEQ = 4096, MTOK = NB * SEQ, CTXL = 256, NCTX = NB * CTXL;
constexpr int HD = 128, NQH = 16, NKVH = 4, KVW = 512, FW = 1024, INW = 8192, DFF = 8192, NMOD = 6;
constexpr int SKV = SEQ + CTXL;
constexpr float EPS = 1e-6f;

constexpr size_t MiB = 1u << 20;
constexpr size_t WS_MOD = 0;
constexpr size_t WS_BAR = 192 * 1024;
constexpr size_t WS_CSD = 256 * 1024;
constexpr size_t WS_KCRAW = 512 * 1024;
constexpr size_t WS_WIN = 1 * MiB;
constexpr size_t WS_WO = 33 * MiB;
constexpr size_t WS_WFG = 41 * MiB;
constexpr size_t WS_WOUT = 45 * MiB;
constexpr size_t WS_WFP = 53 * MiB;
constexpr size_t WS_CSN = 61 * MiB;
constexpr size_t WS_W1 = 93 * MiB;
constexpr size_t WS_W2 = 329 * MiB;
constexpr size_t WS_ET = 361 * MiB;
constexpr size_t WS_OT = 369 * MiB;
constexpr size_t WS_XN = 125 * MiB;
constexpr size_t WS_G = 159 * MiB;
constexpr size_t WS_Q = 223 * MiB;
constexpr size_t WS_O = 255 * MiB;
constexpr size_t WS_HB = 159 * MiB;
constexpr size_t WS_KRAW = 287 * MiB;
constexpr size_t WS_KALL = 295 * MiB;
constexpr size_t WS_VALL = 304 * MiB;
constexpr size_t WS_UT = 313 * MiB;
constexpr size_t WS_END = 377 * MiB;

constexpr int LDS_BYTES = 131072 + 1024;

__device__ __forceinline__ unsigned cvt_pk_bf16(float lo, float hi) { unsigned r; asm volatile("v_cvt_pk_bf16_f32 %0, %1, %2" : "=v"(r) : "v"(lo), "v"(hi)); return r; }
__device__ __forceinline__ float bf_lo(unsigned w) { return __uint_as_float(w << 16); }
__device__ __forceinline__ float bf_hi(unsigned w) { return __uint_as_float(w & 0xffff0000u); }
__device__ __forceinline__ float sigmoidf_(float v) { return 1.0f / (1.0f + __expf(-v)); }
__device__ __forceinline__ float wave_sum(float v) {
#pragma unroll
    for (int o = 1; o < 64; o <<= 1) v += __shfl_xor(v, o);
    return v;
}

__device__ __forceinline__ int lane_now() { int l; asm volatile("v_mbcnt_lo_u32_b32 %0, -1, 0\n\tv_mbcnt_hi_u32_b32 %0, -1, %0" : "=v"(l)); return l; }

namespace pg8 {
constexpr int BM = 256, BK = 64, HALF = 128, HTB = HALF * BK * 2, STAGE_BYTES = 8 * HTB, NXCD = 8, WGM = 8;
__host__ __device__ __forceinline__ int lds_byte(int r, int c) { const int st = (r >> 4) * 2 + (c >> 5), rr = r & 15, cc = c & 31, ob = rr * 64 + cc * 2; return st * 1024 + (ob ^ (((ob >> 9) & 1) << 5)); }
__host__ __device__ __forceinline__ void stage_rc(int b, int& R, int& C) { const int st = b / 1024, sb = b % 1024, swz = sb ^ (((sb >> 9) & 1) << 5); R = (st >> 1) * 16 + swz / 64; C = (st & 1) * 32 + (swz % 64) / 2; }
__host__ __device__ __forceinline__ int perm32(int rho) { const int n = rho >> 4, i = rho & 15; return 8 * (i >> 2) + 4 * n + (i & 3); }

struct Unit { int pm, pn, kind, aux; };

__device__ __forceinline__ void tile_map(int L, int nM, int nN, int& pm, int& pn) {
    const int nwg = nM * nN; int wgid = L;
    { const int q = nwg / NXCD, r = nwg % NXCD, xcd = wgid % NXCD, off = wgid / NXCD; wgid = (xcd < r ? xcd * (q + 1) : r * (q + 1) + (xcd - r) * q) + off; }
    const int nig = WGM * nN, gid = wgid / nig, fm = gid * WGM, gsz = (nM - fm) < WGM ? (nM - fm) : WGM;
    pm = fm + ((wgid % nig) % gsz); pn = (wgid % nig) / gsz;
}

template <class Epi, class Sched, class Prob>
__device__ __forceinline__ void gemm_phase(LAS unsigned char* lds, const int wid, const int K, const Sched& S, const Prob& P, const Epi& E) {
    const int lane = lane_now(), tid = wid * 64 + lane, wr = wid >> 2, wc = wid & 3;
    const int nt = K / BK;
    unsigned voffA[2], voffB[2];
#pragma unroll
    for (int i = 0; i < 2; ++i) { int R, C; stage_rc(tid * 16 + i * 8192, R, C); const int Rb = (R & ~31) + perm32(R & 31);
        voffA[i] = (unsigned)(R * K + C) * 2u; voffB[i] = (unsigned)(Rb * K + C) * 2u; }
    const size_t kstep = (size_t)(BK * 2);
    const size_t hstep = (size_t)HALF * K * 2;
    const unsigned ldsw = (unsigned)wid * 1024u;
    const int aoff = lds_byte(wr * 64 + (lane & 15), (lane >> 4) * 8), boff = lds_byte(wc * 32 + (lane & 15), (lane >> 4) * 8);
#define PG8_SA(b, h) (((b) * 2 + (h)) * HTB)
#define PG8_SB(b, h) ((4 + (b) * 2 + (h)) * HTB)
#define PG8_STAGE(bufoff, gbase, voff) do { _Pragma("unroll") for (int _i = 0; _i < 2; ++_i) \
        __builtin_amdgcn_global_load_lds((const unsigned*)((const char*)(gbase) + (voff)[_i]), (LAS unsigned*)(lds + (bufoff) + ldsw + _i * 8192), 16, 0, 0); } while (0)
#define PG8_LDA(dst, b, h) do { _Pragma("unroll") for (int m = 0; m < 4; ++m) _Pragma("unroll") for (int k = 0; k < 2; ++k) dst[m][k] = *(const LAS bf16x8*)(lds + PG8_SA(b, h) + aoff + m * 2048 + k * 1024); } while (0)
#define PG8_LDB(dst, b, h) do { _Pragma("unroll") for (int n = 0; n < 2; ++n) _Pragma("unroll") for (int k = 0; k < 2; ++k) dst[n][k] = *(const LAS bf16x8*)(lds + PG8_SB(b, h) + boff + n * 2048 + k * 1024); } while (0)
#define PG8_MMA(ai, bj, At, Bt) do { __builtin_amdgcn_s_setprio(1); _Pragma("unroll") for (int m = 0; m < 4; ++m) _Pragma("unroll") for (int n = 0; n < 2; ++n) _Pragma("unroll") for (int k = 0; k < 2; ++k) \
        acc[ai][bj][m][n] = __builtin_amdgcn_mfma_f32_16x16x32_bf16(Bt[n][k], At[m][k], acc[ai][bj][m][n], 0, 0, 0); __builtin_amdgcn_s_setprio(0); } while (0)
#define PG8_WAIT_V(n) asm volatile("s_waitcnt vmcnt(" #n ")" ::: "memory")
#define PG8_WAIT_L(n) asm volatile("s_waitcnt lgkmcnt(" #n ")" ::: "memory")
#define PG8_BAR __builtin_amdgcn_s_barrier()
#define PG8_SCHED __builtin_amdgcn_sched_barrier(0)
    Unit cur, nxt; int ui = 0;
    if (!S.next(0, cur)) return;
    f32x4 acc[2][2][4][2];
#pragma unroll
    for (int a = 0; a < 2; ++a)
#pragma unroll
        for (int b = 0; b < 2; ++b)
#pragma unroll
            for (int m = 0; m < 4; ++m)
#pragma unroll
                for (int n = 0; n < 2; ++n) acc[a][b][m][n] = (f32x4){0.f, 0.f, 0.f, 0.f};
    bf16x8 At[4][2], B0[2][2], B1[2][2];
    const char* cA = P.A(cur); const char* cB = P.B(cur);
    PG8_STAGE(PG8_SB(0, 0), cB, voffB); PG8_STAGE(PG8_SB(0, 1), cB + hstep, voffB); PG8_STAGE(PG8_SA(0, 0), cA, voffA); PG8_STAGE(PG8_SA(0, 1), cA + hstep, voffA);
    if (wr == 1) PG8_BAR;
    PG8_WAIT_V(2); PG8_BAR;
    PG8_STAGE(PG8_SB(1, 0), cB + kstep, voffB); PG8_STAGE(PG8_SA(1, 0), cA + kstep, voffA); PG8_STAGE(PG8_SB(1, 1), cB + hstep + kstep, voffB);
    PG8_WAIT_V(6); PG8_BAR;
    for (;;) {
        const bool has_next = S.next(ui + 1, nxt);
        const char* nA = has_next ? P.A(nxt) : cA; const char* nB = has_next ? P.B(nxt) : cB;
        for (int t = 0; t < nt; t += 2) {
            const bool last = (t == nt - 2);
            const char* a1 = cA + (size_t)(t + 1) * kstep;
            const char* a2 = last ? nA : cA + (size_t)(t + 2) * kstep; const char* b2 = last ? nB : cB + (size_t)(t + 2) * kstep;
            const char* a3 = a2 + kstep; const char* b3 = b2 + kstep;
            PG8_LDB(B0, 0, 0); PG8_LDB(B1, 0, 1); PG8_SCHED; PG8_LDA(At, 0, 0); PG8_STAGE(PG8_SA(1, 1), a1 + hstep, voffA);
            PG8_WAIT_V(8); PG8_WAIT_L(0); PG8_BAR; PG8_MMA(0, 0, At, B0); PG8_MMA(0, 1, At, B1); PG8_BAR; PG8_SCHED;
            PG8_LDA(At, 0, 1); PG8_STAGE(PG8_SB(0, 0), b2, voffB); PG8_STAGE(PG8_SB(0, 1), b2 + hstep, voffB); PG8_STAGE(PG8_SA(0, 0), a2, voffA);
            PG8_WAIT_V(8); PG8_WAIT_L(0); PG8_BAR; PG8_MMA(1, 0, At, B0); PG8_MMA(1, 1, At, B1); PG8_BAR; PG8_SCHED;
            PG8_LDB(B0, 1, 0); PG8_LDB(B1, 1, 1); PG8_SCHED; PG8_LDA(At, 1, 0); PG8_STAGE(PG8_SA(0, 1), a2 + hstep, voffA);
            PG8_WAIT_V(8); PG8_WAIT_L(0); PG8_BAR; PG8_MMA(0, 0, At, B0); PG8_MMA(0, 1, At, B1); PG8_BAR; PG8_SCHED;
            PG8_LDA(At, 1, 1); PG8_STAGE(PG8_SB(1, 0), b3, voffB); PG8_STAGE(PG8_SB(1, 1), b3 + hstep, voffB); PG8_STAGE(PG8_SA(1, 0), a3, voffA);
            PG8_WAIT_V(8); PG8_WAIT_L(0); PG8_BAR; PG8_MMA(1, 0, At, B0); PG8_MMA(1, 1, At, B1); PG8_BAR; PG8_SCHED;
        }
        if (wr == 0) PG8_BAR;
        { const int l2 = lane_now(); E(acc, cur, wr, wc, l2 & 15, l2 >> 4); }
        if (!has_next) break;
#pragma unroll
        for (int a = 0; a < 2; ++a)
#pragma unroll
            for (int b = 0; b < 2; ++b)
#pragma unroll
                for (int m = 0; m < 4; ++m)
#pragma unroll
                    for (int n = 0; n < 2; ++n) acc[a][b][m][n] = (f32x4){0.f, 0.f, 0.f, 0.f};
        cur = nxt; cA = nA; cB = nB; ++ui;
        if (wr == 1) PG8_BAR;
    }
    PG8_WAIT_V(0);
    PG8_BAR;
#undef PG8_SA
#undef PG8_SB
#undef PG8_STAGE
#undef PG8_LDA
#undef PG8_LDB
#undef PG8_MMA
#undef PG8_WAIT_V
#undef PG8_WAIT_L
#undef PG8_BAR
#undef PG8_SCHED
}

__device__ __forceinline__ void store_tile_bf16(const f32x4 (&acc)[2][2][4][2], bf16_t* dst, size_t pitch, float sc, int wr, int wc, int fr, int fq) {
    asm volatile("" : "+v"(fr), "+v"(fq));
    const unsigned lo = (unsigned)(wr * 64 + fr) * (unsigned)pitch + (unsigned)(wc * 32 + 8 * fq);
#pragma unroll
    for (int ai = 0; ai < 2; ++ai)
#pragma unroll
        for (int m = 0; m < 4; ++m) { bf16_t* rowu = dst + (size_t)(ai * HALF + m * 16) * pitch;
#pragma unroll
            for (int bj = 0; bj < 2; ++bj) { const f32x4 v0 = acc[ai][bj][m][0] * sc, v1 = acc[ai][bj][m][1] * sc;
                u32x4 w; w.x = cvt_pk_bf16(v0[0], v0[1]); w.y = cvt_pk_bf16(v0[2], v0[3]); w.z = cvt_pk_bf16(v1[0], v1[1]); w.w = cvt_pk_bf16(v1[2], v1[3]);
                *(u32x4*)(rowu + bj * HALF + lo) = w; } }
}
}

namespace att {
using bf16 = __hip_bfloat16;
constexpr int D = 128, NW = 8, QBLK = 32, KVBLK = 64;
constexpr float SCALE = 0.088388347648318440f;
constexpr float THR = 8.f;
constexpr int LDQ = DM, LDK = KVW, LDO = DM;
constexpr size_t SHM_V = KVBLK * D * 2, SHM_K = KVBLK * D * 2, SHM_ATTN = 2 * SHM_V + 2 * SHM_K + NW * 64 * 4;
using s16x4 = __attribute__((ext_vector_type(4))) short;
using f32x16 = __attribute__((ext_vector_type(16))) float;
#define KSWZ(row, colB) ((row) * 256 + ((colB) ^ (((row) & 7) << 4)))
#define SBAR() __builtin_amdgcn_sched_barrier(0)
__device__ __forceinline__ int crow(int r, int hi) { return (r & 3) + 8 * (r >> 2) + 4 * hi; }
__device__ __forceinline__ unsigned cvtpk(float lo, float hi) { unsigned r; asm volatile("v_cvt_pk_bf16_f32 %0, %1, %2" : "=v"(r) : "v"(lo), "v"(hi)); return r; }
__device__ __forceinline__ void partialSM(f32x16& p0, f32x16& p1, float& m_reg, float& mn, float& alpha) {
  constexpr float C = SCALE * 1.4426950408889634f;
  float pmax = p0[0]; for (int r = 1; r < 16; ++r) pmax = fmaxf(pmax, p0[r]); for (int r = 0; r < 16; ++r) pmax = fmaxf(pmax, p1[r]);
  { auto rr = __builtin_amdgcn_permlane32_swap(__float_as_uint(pmax), __float_as_uint(pmax), false, false);
    pmax = fmaxf(__uint_as_float(rr[0]), __uint_as_float(rr[1])); }
  if (__builtin_expect(__all(pmax - m_reg <= THR / SCALE), 1)) { mn = m_reg; alpha = 1.f; }
  else { mn = fmaxf(m_reg, pmax); alpha = __builtin_amdgcn_exp2f((m_reg - mn) * C); m_reg = mn; }
  float mnC = -mn * C;
  for (int r = 0; r < 16; ++r) p0[r] = fmaf(p0[r], C, mnC); for (int r = 0; r < 16; ++r) p1[r] = fmaf(p1[r], C, mnC);
  for (int r = 0; r < 16; ++r) p0[r] = __builtin_amdgcn_exp2f(p0[r]);
}
__device__ __forceinline__ void finishSM(f32x16& p0, f32x16& p1, float alpha, float& l_reg, bf16x8& pa0, bf16x8& pa1, bf16x8& pa2, bf16x8& pa3) {
  for (int r = 0; r < 16; ++r) p1[r] = __builtin_amdgcn_exp2f(p1[r]);
  float ps = 0; for (int r = 0; r < 16; ++r) ps += p0[r]; for (int r = 0; r < 16; ++r) ps += p1[r];
  { auto rr = __builtin_amdgcn_permlane32_swap(__float_as_uint(ps), __float_as_uint(ps), false, false);
    ps = __uint_as_float(rr[0]) + __uint_as_float(rr[1]); }
  l_reg = l_reg * alpha + ps;
#define PK4(P, BASE, OUT) do { unsigned a0 = cvtpk(P[BASE + 0], P[BASE + 1]), a1 = cvtpk(P[BASE + 2], P[BASE + 3]);   \
    unsigned b0 = cvtpk(P[BASE + 4], P[BASE + 5]), b1 = cvtpk(P[BASE + 6], P[BASE + 7]);                              \
    auto r0 = __builtin_amdgcn_permlane32_swap(a0, b0, false, false); auto r1 = __builtin_amdgcn_permlane32_swap(a1, b1, false, false); \
    u32x4 w = {r0[0], r1[0], r0[1], r1[1]}; OUT = *reinterpret_cast<bf16x8*>(&w); } while (0)
  PK4(p0, 0, pa0); PK4(p0, 8, pa1); PK4(p1, 0, pa2); PK4(p1, 8, pa3);
#undef PK4
}
__device__ __forceinline__ void qkt(f32x16& p0, f32x16& p1, const bf16* Ks, const bf16x8* qr, int r32, int hi) {
  p0 = f32x16{}; p1 = f32x16{};
  for (int d0 = 0; d0 < 8; ++d0) { int cb = (d0 * 16 + hi * 8) * 2;
    bf16x8 b0 = *reinterpret_cast<const bf16x8*>((const char*)Ks + KSWZ(r32, cb));
    bf16x8 b1 = *reinterpret_cast<const bf16x8*>((const char*)Ks + KSWZ(32 + r32, cb));
    p0 = __builtin_amdgcn_mfma_f32_32x32x16_bf16(b0, qr[d0], p0, 0, 0, 0);
    p1 = __builtin_amdgcn_mfma_f32_32x32x16_bf16(b1, qr[d0], p1, 0, 0, 0); }
}
__device__ __forceinline__ int v_st(int k, int c) { const int kk = (k & ~0xC) | ((k & 4) << 1) | ((k & 8) >> 1); return ((kk >> 3) * 4 + (c >> 5)) * 512 + ((kk & 7) * 32 + (c & 31)) * 2; }
__device__ __forceinline__ int v_rd_base(int lane) { return ((lane & 3) << 3) | (((lane >> 2) & 3) << 6) | (((lane >> 4) & 1) << 5) | (((lane >> 5) & 1) << 8); }
constexpr int v_rd_off(int d0, int ks, int half) { return d0 * 512 + ks * 4096 + half * 2048; }
template <int OFF> __device__ __forceinline__ s16x4 tr_read(int vb) {
  s16x4 r; asm volatile("ds_read_b64_tr_b16 %0, %1 offset:%2" : "=&v"(r) : "v"(vb), "i"(OFF) : "memory"); return r;
}
template <int D0> __device__ __forceinline__ void pv_one(f32x16& od, int vb, bf16x8 pa0, bf16x8 pa1, bf16x8 pa2, bf16x8 pa3) {
  const s16x4 l0 = tr_read<v_rd_off(D0, 0, 0)>(vb), h0 = tr_read<v_rd_off(D0, 0, 1)>(vb), l1 = tr_read<v_rd_off(D0, 1, 0)>(vb), h1 = tr_read<v_rd_off(D0, 1, 1)>(vb);
  const s16x4 l2 = tr_read<v_rd_off(D0, 2, 0)>(vb), h2 = tr_read<v_rd_off(D0, 2, 1)>(vb), l3 = tr_read<v_rd_off(D0, 3, 0)>(vb), h3 = tr_read<v_rd_off(D0, 3, 1)>(vb);
  asm volatile("s_waitcnt lgkmcnt(0)" ::: "memory"); SBAR();
#define PK(L, H) (bf16x8){L[0], L[1], L[2], L[3], H[0], H[1], H[2], H[3]}
  od = __builtin_amdgcn_mfma_f32_32x32x16_bf16(pa0, PK(l0, h0), od, 0, 0, 0);
  od = __builtin_amdgcn_mfma_f32_32x32x16_bf16(pa1, PK(l1, h1), od, 0, 0, 0);
  od = __builtin_amdgcn_mfma_f32_32x32x16_bf16(pa2, PK(l2, h2), od, 0, 0, 0);
  od = __builtin_amdgcn_mfma_f32_32x32x16_bf16(pa3, PK(l3, h3), od, 0, 0, 0);
#undef PK
}
__device__ __forceinline__ void pv_d0(f32x16* o, int vb, bf16x8 pa0, bf16x8 pa1, bf16x8 pa2, bf16x8 pa3) {
  pv_one<0>(o[0], vb, pa0, pa1, pa2, pa3); pv_one<1>(o[1], vb, pa0, pa1, pa2, pa3); pv_one<2>(o[2], vb, pa0, pa1, pa2, pa3); pv_one<3>(o[3], vb, pa0, pa1, pa2, pa3);
}

__device__ __forceinline__ void attn_dense_body(const bf16* __restrict__ Qb, const bf16* __restrict__ Kh, const bf16* __restrict__ Vh,
                                                bf16* __restrict__ Ob, int seq, char* lds, const int wid) {
  const int lane = lane_now(), tid = wid * 64 + lane, r32 = lane & 31, hi = lane >> 5;
  bf16* V_lds = (bf16*)lds; bf16* K_lds = (bf16*)(lds + 2 * SHM_V);
  float* ws = (float*)(lds + 2 * SHM_V + 2 * SHM_K) + wid * 64; float* li_l = ws; float* al_l = ws + 32;
  float m_reg = -1e30f, l_reg = 0; f32x16 o[4] = {}; bf16x8 qr[8];
  const bf16* Qw = Qb + (long)(wid * QBLK + r32) * LDQ + hi * 8;
#pragma unroll
  for (int d0 = 0; d0 < 8; ++d0) qr[d0] = *reinterpret_cast<const bf16x8*>(Qw + d0 * 16);
  const int sr = tid >> 4, sc = (tid & 15) * 8, vst0 = v_st(sr, sc), vst1 = v_st(32 + sr, sc);
  const int vb0 = (int)(uintptr_t)V_lds + v_rd_base(lane);
  struct { bf16x8 vs0, vs1, ks0, ks1; } sr_[2];
#define SLOAD(i, k0) do { sr_[i].vs0 = *reinterpret_cast<const bf16x8*>(&Vh[(long)((k0) + sr) * LDK + sc]); sr_[i].vs1 = *reinterpret_cast<const bf16x8*>(&Vh[(long)((k0) + 32 + sr) * LDK + sc]); \
    sr_[i].ks0 = *reinterpret_cast<const bf16x8*>(&Kh[(long)((k0) + sr) * LDK + sc]); sr_[i].ks1 = *reinterpret_cast<const bf16x8*>(&Kh[(long)((k0) + 32 + sr) * LDK + sc]); } while (0)
#define SWRITE(b, i) do { *(bf16x8*)((char*)V_lds + (b) * SHM_V + vst0) = sr_[i].vs0;          \
    *(bf16x8*)((char*)V_lds + (b) * SHM_V + vst1) = sr_[i].vs1; int kc = sc * 2;               \
    *(bf16x8*)((char*)K_lds + (b) * SHM_K + KSWZ(sr, kc)) = sr_[i].ks0;                       \
    *(bf16x8*)((char*)K_lds + (b) * SHM_K + KSWZ(32 + sr, kc)) = sr_[i].ks1; } while (0)
#define SWAIT() asm volatile("s_waitcnt vmcnt(4)" ::: "memory")
#define RESC(a) do { if (__any((a) < 1.f)) { if (hi == 0) al_l[r32] = (a); asm volatile("s_waitcnt lgkmcnt(0)" ::: "memory"); \
    for (int d = 0; d < 4; ++d) for (int r = 0; r < 16; ++r) o[d][r] *= al_l[crow(r, hi)]; } } while (0)
  f32x16 pA0, pA1, pB0, pB1; float mnA, mnB, alA, alB; bf16x8 pa0, pa1, pa2, pa3; const int NT = seq / KVBLK;
  constexpr int SE = 0, SO = 1;
  SLOAD(SE, 0); asm volatile("s_waitcnt vmcnt(0)" ::: "memory"); SWRITE(0, SE); __syncthreads();
  qkt(pA0, pA1, K_lds, qr, r32, hi); partialSM(pA0, pA1, m_reg, mnA, alA);
  SLOAD(SO, KVBLK); if (2 < NT) SLOAD(SE, 2 * KVBLK);
  SWAIT(); SWRITE(1, SO); __syncthreads();
  for (int j = 1; j + 1 < NT; j += 2) {
    SBAR(); qkt(pB0, pB1, (bf16*)((char*)K_lds + SHM_K), qr, r32, hi);
    finishSM(pA0, pA1, alA, l_reg, pa0, pa1, pa2, pa3); SBAR();
    SLOAD(SO, (j + 2) * KVBLK); SBAR();
    pv_d0(o, vb0, pa0, pa1, pa2, pa3); partialSM(pB0, pB1, m_reg, mnB, alB);
    __syncthreads(); SWAIT(); SWRITE(0, SE);
    RESC(alB); __syncthreads();
    SBAR(); qkt(pA0, pA1, K_lds, qr, r32, hi);
    finishSM(pB0, pB1, alB, l_reg, pa0, pa1, pa2, pa3); SBAR();
    if (j + 3 < NT) SLOAD(SE, (j + 3) * KVBLK); SBAR();
    pv_d0(o, vb0 + (int)SHM_V, pa0, pa1, pa2, pa3); partialSM(pA0, pA1, m_reg, mnA, alA);
    __syncthreads(); SWAIT(); SWRITE(1, SO);
    RESC(alA); __syncthreads();
  }
  SBAR(); qkt(pB0, pB1, (bf16*)((char*)K_lds + SHM_K), qr, r32, hi);
  finishSM(pA0, pA1, alA, l_reg, pa0, pa1, pa2, pa3); SBAR();
  pv_d0(o, vb0, pa0, pa1, pa2, pa3); partialSM(pB0, pB1, m_reg, mnB, alB);
  __syncthreads(); RESC(alB);
  finishSM(pB0, pB1, alB, l_reg, pa0, pa1, pa2, pa3); SBAR();
  pv_d0(o, vb0 + (int)SHM_V, pa0, pa1, pa2, pa3);
  if (hi == 0) li_l[r32] = l_reg; asm volatile("s_waitcnt lgkmcnt(0)" ::: "memory");
  float rli[16];
#pragma unroll
  for (int r = 0; r < 16; ++r) rli[r] = __builtin_amdgcn_rcpf(li_l[crow(r, hi)]);
  bf16* Ow = Ob + (long)(wid * QBLK) * LDO;
#pragma unroll
  for (int r = 0; r < 16; ++r) { int orow = crow(r, hi);
    for (int d0 = 0; d0 < 4; ++d0) Ow[(long)orow * LDO + d0 * 32 + r32] = __float2bfloat16(o[d0][r] * rli[r]); }
  __syncthreads();
#undef SLOAD
#undef SWRITE
#undef SWAIT
#undef RESC
}
#undef KSWZ
#undef SBAR
}

#define XB_TMO      128
#define XB_XCNT(j)  (256  + 64 * (j))
#define XB_XSUB(j)  (1280 + 64 * (j))
#define XB_XGEN(j)  (2304 + 64 * (j))
#define XB_TOP      3328
#define XB_TOPGEN   3392
#define XCD_BAR_WORDS 3456
#define XB_SPIN_CAP (1u << 18)
__device__ __forceinline__ unsigned xb_ld(unsigned* p)              { return __hip_atomic_load(p, __ATOMIC_RELAXED, __HIP_MEMORY_SCOPE_AGENT); }
__device__ __forceinline__ unsigned xb_add(unsigned* p, unsigned v) { return __hip_atomic_fetch_add(p, v, __ATOMIC_RELAXED, __HIP_MEMORY_SCOPE_AGENT); }
__device__ __forceinline__ unsigned xb_xcc_id() { return (unsigned)__builtin_amdgcn_s_getreg((3 << 11) | 20) & 0xFu; }
#define XB_SPIN(cond, bar) do { unsigned _sp = 0; while (cond) { __builtin_amdgcn_s_sleep(1); \
    if ((++_sp & 255u) == 0u) { if (xb_ld(&(bar)[XB_TMO])) break; if (_sp > XB_SPIN_CAP) { atomicAdd(&(bar)[XB_TMO], 1u); break; } } } } while (0)
struct XcdBarrier { unsigned* bar; unsigned x; volatile LAS unsigned* st; };
__device__ __forceinline__ XcdBarrier xcd_barrier_post(unsigned* bar, volatile LAS unsigned* st, int wave) {
    XcdBarrier b; b.bar = bar; b.x = xb_xcc_id(); b.st = st;
    if (wave == 0 && lane_now() == 0) (void)xb_add(&bar[XB_XCNT(b.x)], 1u);
    return b;
}
__device__ __forceinline__ void xcd_barrier_complete(unsigned* bar, unsigned x, unsigned& nloc, unsigned& nx) {
    const unsigned G = gridDim.x * gridDim.y * gridDim.z;
    unsigned sum, cnt, mine, sp = 0u;
    for (;;) {
        sum = 0u; cnt = 0u; mine = 0u;
#pragma unroll
        for (unsigned j = 0; j < 16; ++j) { const unsigned c = xb_ld(&bar[XB_XCNT(j)]); sum += c; cnt += (c > 0u) ? 1u : 0u; mine = (j == x) ? c : mine; }
        if (sum == G) break;
        __builtin_amdgcn_s_sleep(1);
        if ((++sp & 255u) == 0u) { if (xb_ld(&bar[XB_TMO])) break; if (sp > XB_SPIN_CAP) { atomicAdd(&bar[XB_TMO], 1u); break; } }
    }
    nloc = mine > 0u ? mine : 1u; nx = cnt > 0u ? cnt : 1u;
}
__device__ __forceinline__ void xcd_barrier(const XcdBarrier& b, int wave) {
    asm volatile("s_waitcnt vmcnt(0)" ::: "memory");
    __syncthreads();
    if (wave == 0 && lane_now() == 0) {
        unsigned* bar = b.bar;
        __builtin_amdgcn_s_waitcnt(0);
        unsigned nloc = b.st[0], nx = b.st[1];
        if (nloc == 0u) { xcd_barrier_complete(bar, b.x, nloc, nx); b.st[0] = nloc; b.st[1] = nx; }
        const unsigned old = xb_add(&bar[XB_XSUB(b.x)], 1u);
        const unsigned gen = old / nloc;
        if (old + 1u == (gen + 1u) * nloc) {
            __builtin_amdgcn_fence(__ATOMIC_RELEASE, "agent");
            asm volatile("s_waitcnt vmcnt(0)" ::: "memory");
            const unsigned og = xb_add(&bar[XB_TOP], 1u);
            const unsigned tg = og / nx;
            if (og + 1u == (tg + 1u) * nx) xb_add(&bar[XB_TOPGEN], 1u);
            else XB_SPIN(xb_ld(&bar[XB_TOPGEN]) == tg, bar);
            __builtin_amdgcn_fence(__ATOMIC_ACQUIRE, "agent");
            xb_add(&bar[XB_XGEN(b.x)], 1u);
            asm volatile("s_waitcnt vmcnt(0)" ::: "memory");
        } else {
            XB_SPIN(xb_ld(&bar[XB_XGEN(b.x)]) == gen, bar);
            __builtin_amdgcn_fence(__ATOMIC_ACQUIRE, "agent");
            asm volatile("s_waitcnt vmcnt(0)" ::: "memory");
        }
    }
    __syncthreads();
}

struct Args { const float* in[17]; float* out; unsigned char* ws; int ph_lo, ph_hi; };
enum { I_X = 0, I_C, I_CTX, I_CCTX, I_WADA, I_BADA, I_N1G, I_WIN, I_QNG, I_KNG, I_WAO, I_WF, I_WOUT, I_N2G, I_W1, I_W2, I_FNG };

struct Frame {
    LAS unsigned char* lds;
    int wave, G, bid;
};

__device__ __forceinline__ void transpose_item(const float* W, int ldw, int k0, int n0, bf16_t* dst, int dpitch, LAS float* scr, int lane) {
#pragma unroll 8
    for (int i = 0; i < 32; ++i) { const int kk = 2 * i + (lane >> 5); scr[kk * 33 + (lane & 31)] = W[(size_t)(k0 + kk) * ldw + n0 + (lane & 31)]; }
    asm volatile("s_waitcnt lgkmcnt(0)" ::: "memory");
    const int c = lane & 7;
#pragma unroll
    for (int j = 0; j < 4; ++j) { const int n = (lane >> 3) + 8 * j; const LAS float* s = scr + (8 * c) * 33 + n;
        u32x4 o; o.x = cvt_pk_bf16(s[0 * 33], s[1 * 33]); o.y = cvt_pk_bf16(s[2 * 33], s[3 * 33]); o.z = cvt_pk_bf16(s[4 * 33], s[5 * 33]); o.w = cvt_pk_bf16(s[6 * 33], s[7 * 33]);
        *(u32x4*)(dst + (size_t)n * dpitch + 8 * c) = o; }
    asm volatile("s_waitcnt lgkmcnt(0)" ::: "memory");
}

__device__ __forceinline__ void norm_mod_rows(const float* src, bf16_t* dst, const float* gam, const float* sc, const float* sh, int r0, int cnt, int lane) {
    f32x4 A[8], Bv[8];
#pragma unroll
    for (int j = 0; j < 8; ++j) { const int c = 4 * lane + 256 * j; const f32x4 g = *(const f32x4*)(gam + c); const f32x4 s = *(const f32x4*)(sc + c); A[j] = g * (s + 1.0f); Bv[j] = *(const f32x4*)(sh + c); }
    for (int r = r0; r < r0 + cnt; ++r) {
        const f32x4* xr = (const f32x4*)(src + (size_t)r * DM) + lane;
        f32x4 v[8]; float ss = 0.f;
#pragma unroll
        for (int j = 0; j < 8; ++j) { v[j] = xr[64 * j]; ss += (v[j].x * v[j].x + v[j].y * v[j].y) + (v[j].z * v[j].z + v[j].w * v[j].w); }
        const float rstd = 1.0f / sqrtf(wave_sum(ss) * (1.0f / DM) + EPS);
        u32x2* o8 = (u32x2*)(dst + (size_t)r * DM) + lane;
#pragma unroll
        for (int j = 0; j < 8; ++j) { const f32x4 y = v[j] * rstd * A[j] + Bv[j]; u32x2 w; w.x = cvt_pk_bf16(y.x, y.y); w.y = cvt_pk_bf16(y.z, y.w); o8[64 * j] = w; }
    }
}

using pg8::Unit;
struct SchedWfp { int G, c; __device__ bool next(int i, Unit& u) const { const int L = i * G + c; if (L >= 64) return false; u.aux = L >> 4; const int l = L & 15; u.pm = l & 7; u.pn = l >> 3; u.kind = 0; return true; } };
struct ProbWfp { const char* wfg; const char* csd; __device__ const char* A(const Unit& u) const { return wfg + (size_t)u.aux * 2048 * 256 * 2 + (size_t)u.pm * 256 * 256 * 2; } __device__ const char* B(const Unit& u) const { return csd + (size_t)u.pn * 256 * 256 * 2; } };
struct EpiWfp { bf16_t* wfp; __device__ void operator()(const f32x4 (&acc)[2][2][4][2], const Unit& u, int wr, int wc, int fr, int fq) const {
    pg8::store_tile_bf16(acc, wfp + (size_t)(u.pm * 256) * 2048 + u.aux * 512 + u.pn * 256, 2048, 1.0f, wr, wc, fr, fq); } };

struct SchedIn { int G, c; __device__ bool next(int i, Unit& u) const { const int L = i * G + c; if (L >= 1032) return false; u.aux = 0;
    if (L < 896) { u.kind = 0; pg8::tile_map(L, 32, 28, u.pm, u.pn); } else if (L < 1024) { u.kind = 1; pg8::tile_map(L - 896, 4, 32, u.pm, u.pn); } else { u.kind = 2; const int l = L - 1024; u.pm = 32 + (l >> 2); u.pn = 8 + (l & 3); } return true; } };
struct ProbIn { const char* xn; const char* win; static constexpr size_t TS = (size_t)256 * 2048 * 2;
    __device__ const char* A(const Unit& u) const { return (u.kind == 1 ? win + (size_t)7168 * 2048 * 2 : xn) + (size_t)u.pm * TS; }
    __device__ const char* B(const Unit& u) const { return (u.kind == 1 ? xn : win) + (size_t)u.pn * TS; } };
struct EpiIn { bf16_t *q, *kraw, *kcraw, *vall, *g, *ut;
    __device__ void operator()(const f32x4 (&acc)[2][2][4][2], const Unit& u, int wr, int wc, int fr, int fq) const {
        bf16_t* dst; size_t pitch;
        if (u.kind == 1) { dst = ut + (size_t)(u.pn >> 4) * 1024 * 4096 + (size_t)(u.pm * 256) * 4096 + (u.pn & 15) * 256; pitch = 4096; }
        else if (u.pn < 8) { dst = q + (size_t)(u.pm * 256) * 2048 + u.pn * 256; pitch = 2048; }
        else if (u.pn < 10) { dst = (u.kind == 0 ? kraw + (size_t)(u.pm * 256) * 512 : kcraw + (size_t)((u.pm - 32) * 256) * 512) + (u.pn - 8) * 256; pitch = 512; }
        else if (u.pn < 12) { const size_t row = (u.kind == 0) ? (size_t)(u.pm * 256 + (u.pm >> 4) * CTXL) : (size_t)((u.pm - 32) * SKV + SEQ); dst = vall + row * 512 + (u.pn - 10) * 256; pitch = 512; }
        else { dst = g + (size_t)(u.pm * 256) * 4096 + (u.pn - 12) * 256; pitch = 4096; }
        pg8::store_tile_bf16(acc, dst, pitch, 1.0f, wr, wc, fr, fq); } };

struct SchedDft { int G, c; __device__ bool next(int i, Unit& u) const { const int L = i * G + c; if (L >= 256) return false; u.aux = L >> 7; u.kind = 0; pg8::tile_map(L & 127, 32, 4, u.pm, u.pn); return true; } };
struct ProbDft { const char* csn; const char* et; const char* ot; static constexpr size_t TS = (size_t)256 * 2048 * 2;
    __device__ const char* A(const Unit& u) const { return csn + (size_t)u.pm * TS; }
    __device__ const char* B(const Unit& u) const { return ((u.pm >> 4) ? ot : et) + (size_t)u.aux * 1024 * 2048 * 2 + (size_t)u.pn * TS; } };
struct EpiDft { bf16_t* zcat; const bf16_t* ut;
    __device__ void operator()(const f32x4 (&acc)[2][2][4][2], const Unit& u, int wr, int wc, int fr, int fq) const {
        asm volatile("" : "+v"(fr), "+v"(fq));
        const int ri = u.pm >> 4; const float sgn = (fr & 1) ? -1.0f : 1.0f;
        bf16_t* dst = zcat + (size_t)(u.aux * SEQ + (u.pm & 15) * 256) * 2048 + u.pn * 512 + ri * 256;
        const unsigned lcol = (unsigned)(wc * 32 + 8 * fq), lo = (unsigned)(wr * 64 + fr) * 2048u + lcol;
        const bf16_t* um = ut + (size_t)u.aux * 1024 * 4096 + (size_t)(u.pn * 256) * 4096 + 2048;
#pragma unroll
        for (int bj = 0; bj < 2; ++bj) { float uh[8];
#pragma unroll
            for (int e = 0; e < 8; ++e) uh[e] = ri ? 0.f : sgn * __uint_as_float((unsigned)um[(size_t)(bj * 128 + lcol + e) * 4096] << 16);
#pragma unroll
            for (int ai = 0; ai < 2; ++ai)
#pragma unroll
                for (int m = 0; m < 4; ++m) { const f32x4 a0 = acc[ai][bj][m][0], a1 = acc[ai][bj][m][1]; const float sc = 1.0f / 1024.0f;
                    u32x4 w; w.x = cvt_pk_bf16((a0[0] + uh[0]) * sc, (a0[1] + uh[1]) * sc); w.y = cvt_pk_bf16((a0[2] + uh[2]) * sc, (a0[3] + uh[3]) * sc);
                    w.z = cvt_pk_bf16((a1[0] + uh[4]) * sc, (a1[1] + uh[5]) * sc); w.w = cvt_pk_bf16((a1[2] + uh[6]) * sc, (a1[3] + uh[7]) * sc);
                    *(u32x4*)(dst + (size_t)(ai * 128 + m * 16) * 2048 + bj * 128 + lo) = w; } }
    } };

struct SchedMerge { int G, c; __device__ bool next(int i, Unit& u) const { const int t = (i >> 1) * G + c; if (t >= 256) return false; u.kind = i & 1; u.aux = 0; pg8::tile_map(t, 32, 8, u.pm, u.pn); return true; } };
struct ProbMerge { const char *o, *zcat, *wo, *wfp; static constexpr size_t TS = (size_t)256 * 2048 * 2;
    __device__ const char* A(const Unit& u) const { return (u.kind ? zcat : o) + (size_t)u.pm * TS; }
    __device__ const char* B(const Unit& u) const { return (u.kind ? wfp : wo) + (size_t)u.pn * TS; } };
struct EpiMerge { const bf16_t* g; float* t1; bf16_t* t;
    __device__ void operator()(const f32x4 (&acc)[2][2][4][2], const Unit& u, int wr, int wc, int fr, int fq) const {
        asm volatile("" : "+v"(fr), "+v"(fq));
        const unsigned lrow = (unsigned)(wr * 64 + fr), lcol = (unsigned)(wc * 32 + 8 * fq);
        const unsigned lo_g = lrow * 4096u + lcol, lo_t = lrow * 2048u + lcol;
        const bf16_t* gu = g + (size_t)(u.pm * 256) * 4096 + (u.kind ? 2048 : 0) + u.pn * 256;
        float* t1u = t1 + (size_t)(u.pm * 256) * 2048 + u.pn * 256; bf16_t* tu = t + (size_t)(u.pm * 256) * 2048 + u.pn * 256;
#pragma unroll
        for (int ai = 0; ai < 2; ++ai)
#pragma unroll
            for (int m = 0; m < 4; ++m) {
#pragma unroll
                for (int bj = 0; bj < 2; ++bj) { const size_t ro = (size_t)(ai * 128 + m * 16);
                    const u32x4 gw = *(const u32x4*)(gu + ro * 4096 + bj * 128 + lo_g);
                    f32x4 v0 = acc[ai][bj][m][0], v1 = acc[ai][bj][m][1];
                    v0.x *= sigmoidf_(bf_lo(gw.x)); v0.y *= sigmoidf_(bf_hi(gw.x)); v0.z *= sigmoidf_(bf_lo(gw.y)); v0.w *= sigmoidf_(bf_hi(gw.y));
                    v1.x *= sigmoidf_(bf_lo(gw.z)); v1.y *= sigmoidf_(bf_hi(gw.z)); v1.z *= sigmoidf_(bf_lo(gw.w)); v1.w *= sigmoidf_(bf_hi(gw.w));
                    float* tp = t1u + ro * 2048 + bj * 128 + lo_t;
                    if (u.kind == 0) { *(f32x4*)tp = v0; *(f32x4*)(tp + 4) = v1; }
                    else { v0 += *(const f32x4*)tp; v1 += *(const f32x4*)(tp + 4);
                        u32x4 w; w.x = cvt_pk_bf16(v0[0], v0[1]); w.y = cvt_pk_bf16(v0[2], v0[3]); w.z = cvt_pk_bf16(v1[0], v1[1]); w.w = cvt_pk_bf16(v1[2], v1[3]);
                        *(u32x4*)(tu + ro * 2048 + bj * 128 + lo_t) = w; } } }
    } };

struct SchedN8 { int G, c; __device__ bool next(int i, Unit& u) const { const int L = i * G + c; if (L >= 256) return false; u.kind = 0; u.aux = 0; pg8::tile_map(L, 32, 8, u.pm, u.pn); return true; } };
struct ProbPlain { const char* a; const char* b; size_t ts; __device__ const char* A(const Unit& u) const { return a + (size_t)u.pm * ts; } __device__ const char* B(const Unit& u) const { return b + (size_t)u.pn * ts; } };
struct EpiRes { const float* res; float* out; const float* gate;
    __device__ void operator()(const f32x4 (&acc)[2][2][4][2], const Unit& u, int wr, int wc, int fr, int fq) const {
        asm volatile("" : "+v"(fr), "+v"(fq));
        const unsigned lcol = (unsigned)(wc * 32 + 8 * fq), lo = (unsigned)(wr * 64 + fr) * 2048u + lcol;
        const float* gb = gate + (size_t)(u.pm >> 4) * (NMOD * DM) + u.pn * 256;
        const float* ru = res + (size_t)(u.pm * 256) * 2048 + u.pn * 256; float* ou = out + (size_t)(u.pm * 256) * 2048 + u.pn * 256;
#pragma unroll
        for (int bj = 0; bj < 2; ++bj) { const f32x4 g0 = *(const f32x4*)(gb + bj * 128 + lcol), g1 = *(const f32x4*)(gb + bj * 128 + lcol + 4);
#pragma unroll
            for (int ai = 0; ai < 2; ++ai)
#pragma unroll
                for (int m = 0; m < 4; ++m) { const size_t ro = (size_t)(ai * 128 + m * 16) * 2048 + bj * 128;
                    const f32x4 r0 = *(const f32x4*)(ru + ro + lo), r1 = *(const f32x4*)(ru + ro + lo + 4);
                    *(f32x4*)(ou + ro + lo) = r0 + g0 * acc[ai][bj][m][0]; *(f32x4*)(ou + ro + lo + 4) = r1 + g1 * acc[ai][bj][m][1]; } }
    } };

struct SchedUp { int G, c; __device__ bool next(int i, Unit& u) const { const int L = i * G + c; if (L >= 1024) return false; u.kind = 0; u.aux = 0; pg8::tile_map(L, 32, 32, u.pm, u.pn); return true; } };
struct EpiUp { bf16_t* hb;
    __device__ void operator()(const f32x4 (&acc)[2][2][4][2], const Unit& u, int wr, int wc, int fr, int fq) const {
        asm volatile("" : "+v"(fr), "+v"(fq));
        const unsigned lo = (unsigned)(wr * 64 + fr) * (unsigned)DFF + (unsigned)(wc * 32 + 8 * fq);
        bf16_t* hu = hb + (size_t)(u.pm * 256) * DFF + u.pn * 256;
#pragma unroll
        for (int ai = 0; ai < 2; ++ai)
#pragma unroll
            for (int m = 0; m < 4; ++m) {
#pragma unroll
                for (int bj = 0; bj < 2; ++bj) { f32x4 v0 = acc[ai][bj][m][0], v1 = acc[ai][bj][m][1];
                    v0.x = fmaxf(v0.x, 0.f); v0.y = fmaxf(v0.y, 0.f); v0.z = fmaxf(v0.z, 0.f); v0.w = fmaxf(v0.w, 0.f); v1.x = fmaxf(v1.x, 0.f); v1.y = fmaxf(v1.y, 0.f); v1.z = fmaxf(v1.z, 0.f); v1.w = fmaxf(v1.w, 0.f);
                    v0 = v0 * v0; v1 = v1 * v1;
                    u32x4 w; w.x = cvt_pk_bf16(v0[0], v0[1]); w.y = cvt_pk_bf16(v0[2], v0[3]); w.z = cvt_pk_bf16(v1[0], v1[1]); w.w = cvt_pk_bf16(v1[2], v1[3]);
                    *(u32x4*)(hu + (size_t)(ai * 128 + m * 16) * DFF + bj * 128 + lo) = w; } }
    } };

constexpr int N_PHASES = 11;

template <bool COOP>
__global__ void __launch_bounds__(512, 2) fwd_kernel(Args args) {
    extern __shared__ __attribute__((aligned(16))) unsigned char lds_raw[];
    Frame F;
    F.lds = (LAS unsigned char*)lds_raw;
    F.wave = __builtin_amdgcn_readfirstlane(threadIdx.x >> 6);
    F.G = gridDim.x; F.bid = blockIdx.x;
    unsigned char* ws = args.ws;
    const int lo = args.ph_lo, hi = args.ph_hi;
    const int gw = F.bid * 8 + F.wave, NGW = F.G * 8;
    const int NGT = F.G * 512;
#define PHASE_IDS() const int lane_ = lane_now(), tid_ = F.wave * 64 + lane_, gt = F.bid * 512 + tid_; (void)gt

    float* mod = (float*)(ws + WS_MOD);
    bf16_t* csd = (bf16_t*)(ws + WS_CSD); bf16_t* kcraw = (bf16_t*)(ws + WS_KCRAW);
    bf16_t* winT = (bf16_t*)(ws + WS_WIN); bf16_t* woT = (bf16_t*)(ws + WS_WO); bf16_t* wfg = (bf16_t*)(ws + WS_WFG); bf16_t* woutT = (bf16_t*)(ws + WS_WOUT);
    bf16_t* wfpT = (bf16_t*)(ws + WS_WFP); bf16_t* csn = (bf16_t*)(ws + WS_CSN); bf16_t* w1T = (bf16_t*)(ws + WS_W1); bf16_t* w2T = (bf16_t*)(ws + WS_W2);
    bf16_t* xn = (bf16_t*)(ws + WS_XN); bf16_t* gbuf = (bf16_t*)(ws + WS_G); bf16_t* qb = (bf16_t*)(ws + WS_Q); bf16_t* ob = (bf16_t*)(ws + WS_O);
    bf16_t* hb = (bf16_t*)(ws + WS_HB); bf16_t* kraw = (bf16_t*)(ws + WS_KRAW); bf16_t* kall = (bf16_t*)(ws + WS_KALL); bf16_t* vall = (bf16_t*)(ws + WS_VALL); bf16_t* ut = (bf16_t*)(ws + WS_UT);
    bf16_t* zcat = xn; bf16_t* tb = qb; float* t1 = args.out; bf16_t* et = (bf16_t*)(ws + WS_ET); bf16_t* ot = (bf16_t*)(ws + WS_OT);

#define IN(k) (lo <= (k) && (k) < hi)
#define SEAM(k) do { if (COOP) { if (IN(k) && IN((k) + 1)) { xcd_barrier(bar, F.wave); } } } while (0)

    volatile LAS unsigned* MISC = (volatile LAS unsigned*)(F.lds + 131072);
    { PHASE_IDS(); if (tid_ < 64) MISC[tid_] = 0u;
    if (COOP && F.bid == 0) { unsigned* bw = (unsigned*)(ws + WS_BAR); for (int i = tid_; i < XCD_BAR_WORDS; i += 512) bw[i] = 0u; } }
    __syncthreads();
    if (IN(0)) { PHASE_IDS();
        {
            LAS float* sv = (LAS float*)(F.lds + 69632);
            LAS float* red = (LAS float*)(F.lds + 94208);
            for (int i = tid_; i < 3 * DM; i += 512) { const float v = (i < 2 * DM) ? args.in[I_C][i] : args.in[I_CCTX][i - 2 * DM]; sv[i] = v / (1.0f + __expf(-v)); }
            __syncthreads();
            const float* wada = args.in[I_WADA];
            for (int cgp = F.bid; cgp < 256; cgp += F.G) {
                const int col = cgp * 48 + (lane_ < 48 ? lane_ : 47);
                float a0 = 0.f, a1 = 0.f, a2 = 0.f;
                const int kb = F.wave * 256;
#pragma unroll 16
                for (int k = 0; k < 256; ++k) { const float w = wada[(size_t)(kb + k) * (NMOD * DM) + col]; a0 += sv[kb + k] * w; a1 += sv[DM + kb + k] * w; a2 += sv[2 * DM + kb + k] * w; }
                if (lane_ < 48) { red[(F.wave * 3 + 0) * 48 + lane_] = a0; red[(F.wave * 3 + 1) * 48 + lane_] = a1; red[(F.wave * 3 + 2) * 48 + lane_] = a2; }
                __syncthreads();
                if (tid_ < 144) { const int j = tid_ / 48, l = tid_ % 48; float s = 0.f;
#pragma unroll
                    for (int w = 0; w < 8; ++w) s += red[(w * 3 + j) * 48 + l];
                    mod[j * (NMOD * DM) + cgp * 48 + l] = s + args.in[I_BADA][cgp * 48 + l]; }
                __syncthreads();
            }
        }
        {
            LAS float* scr = (LAS float*)(F.lds + F.wave * 8448);
            constexpr int I_IN = 32 * 256, I_AO = 32 * 64, I_FO = 16 * 64, I_OUT = 32 * 64, NIT = I_IN + I_AO + I_FO + I_OUT;
            for (int it = gw; it < NIT; it += NGW) {
                int r = it;
                if (r < I_IN) { const int kb = r >> 8, nb = r & 255, n0 = nb * 32; const int drow = n0 < 3072 ? n0 : (n0 < 4096 ? n0 + 4096 : n0 - 1024);
                    transpose_item(args.in[I_WIN], INW, kb * 64, n0, winT + (size_t)drow * DM + kb * 64, DM, scr, lane_); continue; } r -= I_IN;
                if (r < I_AO) { const int kb = r >> 6, nb = r & 63; transpose_item(args.in[I_WAO], DM, kb * 64, nb * 32, woT + (size_t)(nb * 32) * DM + kb * 64, DM, scr, lane_); continue; } r -= I_AO;
                if (r < I_FO) { const int kb = r >> 6, nb = r & 63, k0 = kb * 64, g = k0 >> 8; transpose_item(args.in[I_WF], DM, k0, nb * 32, wfg + ((size_t)g * 2048 + nb * 32) * 256 + (k0 & 255), 256, scr, lane_); continue; } r -= I_FO;
                { const int kb = r >> 6, nb = r & 63; transpose_item(args.in[I_WOUT], DM, kb * 64, nb * 32, woutT + (size_t)(nb * 32) * DM + kb * 64, DM, scr, lane_); }
            }
        }
        for (int it = gt; it < 8192 * 256; it += NGT) { const int R = it >> 8, n0 = (it & 255) * 8, k = R & 4095, ri = R >> 12;
            unsigned w[4];
#pragma unroll
            for (int e = 0; e < 4; ++e) { float v[2];
#pragma unroll
                for (int h = 0; h < 2; ++h) { const int mm = (k * (n0 + 2 * e + h)) & 4095; const float rev = (float)mm * (1.0f / 4096.0f); v[h] = ri ? -__builtin_amdgcn_sinf(rev) : __builtin_amdgcn_cosf(rev); }
                w[e] = cvt_pk_bf16(v[0], v[1]); }
            *(u32x4*)(csn + (size_t)R * 2048 + n0) = (u32x4){w[0], w[1], w[2], w[3]}; }
        for (int it = gt; it < 512 * 32; it += NGT) { const int R = it >> 5, n0 = (it & 31) * 8, k = R & 255, ri = R >> 8;
            unsigned w[4];
#pragma unroll
            for (int e = 0; e < 4; ++e) { float v[2];
#pragma unroll
                for (int h = 0; h < 2; ++h) { const int mm = (k * (n0 + 2 * e + h)) & 255; const float rev = (float)mm * (1.0f / 256.0f); v[h] = ri ? __builtin_amdgcn_sinf(rev) : __builtin_amdgcn_cosf(rev); }
                w[e] = cvt_pk_bf16(v[0], v[1]); }
            *(u32x4*)(csd + (size_t)R * 256 + n0) = (u32x4){w[0], w[1], w[2], w[3]}; }
        __syncthreads();
    }
    XcdBarrier bar; bar.bar = (unsigned*)(ws + WS_BAR); bar.x = 0; bar.st = MISC + 8;
    if (COOP) { cg::this_grid().sync();
        bar = xcd_barrier_post((unsigned*)(ws + WS_BAR), MISC + 8, F.wave); }

    if (IN(1)) { PHASE_IDS();
        {
            for (int it = gw; it < 2048 + 128; it += NGW) {
                if (it < 2048) { const int r0 = it * 4, b = r0 / SEQ; const float* mb = mod + (size_t)b * (NMOD * DM);
                    norm_mod_rows(args.in[I_X], xn, args.in[I_N1G], mb + DM, mb, r0, 4, lane_); }
                else { const int r0 = (it - 2048) * 4; const float* mb = mod + (size_t)2 * (NMOD * DM);
                    norm_mod_rows(args.in[I_CTX], xn + (size_t)MTOK * DM, args.in[I_N1G], mb + DM, mb, r0, 4, lane_); }
            }
        }
        __syncthreads();
        { SchedWfp S{F.G, F.bid}; ProbWfp P{(const char*)wfg, (const char*)csd}; EpiWfp E{wfpT};
          pg8::gemm_phase<EpiWfp, SchedWfp, ProbWfp>(F.lds, F.wave, 256, S, P, E); }
    }
    SEAM(1);

    if (IN(2)) {
        SchedIn S{F.G, F.bid}; ProbIn P{(const char*)xn, (const char*)winT}; EpiIn E{qb, kraw, kcraw, vall, gbuf, ut};
        pg8::gemm_phase<EpiIn, SchedIn, ProbIn>(F.lds, F.wave, 2048, S, P, E);
        { PHASE_IDS(); const int nfull = 1032 % F.G;
          if (F.bid >= nfull) { const int cid = F.bid - nfull, ncv = F.G - nfull;
            LAS float* scr = (LAS float*)(F.lds + F.wave * 8448);
            constexpr int I_1 = 32 * 256, I_2 = 128 * 64;
            for (int it = cid * 8 + F.wave; it < I_1 + I_2; it += ncv * 8) {
                if (it < I_1) { const int kb = it >> 8, nb = it & 255; transpose_item(args.in[I_W1], DFF, kb * 64, nb * 32, w1T + (size_t)(nb * 32) * DM + kb * 64, DM, scr, lane_); }
                else { const int r = it - I_1, kb = r >> 6, nb = r & 63; transpose_item(args.in[I_W2], DM, kb * 64, nb * 32, w2T + (size_t)(nb * 32) * DFF + kb * 64, DFF, scr, lane_); }
            } }
          __syncthreads(); }
    }
    SEAM(2);

    if (IN(3)) { PHASE_IDS();
        LAS f32x2* tab = (LAS f32x2*)F.lds;
        for (int i = tid_; i < 2048; i += 512) { const int idx = i >> 5, j = i & 31; const float inv = __builtin_amdgcn_exp2f(-(float)j * (13.287712379549449f / 32.0f));
            const float ang = (float)idx * inv, rev = ang * 0.15915494309189535f; tab[i] = (f32x2){__builtin_amdgcn_cosf(rev), __builtin_amdgcn_sinf(rev)}; }
        __syncthreads();
        const int l16 = lane_ & 15, sub = lane_ >> 4;
        const f32x4 gq0 = *(const f32x4*)(args.in[I_QNG] + 8 * l16), gq1 = *(const f32x4*)(args.in[I_QNG] + 8 * l16 + 4);
        const f32x4 gk0 = *(const f32x4*)(args.in[I_KNG] + 8 * l16), gk1 = *(const f32x4*)(args.in[I_KNG] + 8 * l16 + 4);
        constexpr int NRQ = MTOK * NQH, NRK = MTOK * NKVH, NRC = NCTX * NKVH, NITEMS = (NRQ + NRK + NRC) / 4;
        for (int it = gw; it < NITEMS; it += NGW) {
            int row = it * 4 + sub; const bf16_t* src; bf16_t* dst; int pos = -1; bool isq = false;
            if (row < NRQ) { const int t = row >> 4, h = row & 15; src = qb + (size_t)t * DM + h * HD; dst = qb + (size_t)t * DM + h * HD; pos = t & (SEQ - 1); isq = true; }
            else if (row < NRQ + NRK) { row -= NRQ; const int t = row >> 2, h = row & 3; src = kraw + (size_t)t * KVW + h * HD; dst = kall + (size_t)(t + (t / SEQ) * CTXL) * KVW + h * HD; pos = t & (SEQ - 1); }
            else { row -= NRQ + NRK; const int t = row >> 2, h = row & 3; src = kcraw + (size_t)t * KVW + h * HD; dst = kall + (size_t)((t / CTXL) * SKV + SEQ + (t % CTXL)) * KVW + h * HD; }
            const u32x4 raw = *(const u32x4*)(src + 8 * l16);
            float v[8] = {bf_lo(raw.x), bf_hi(raw.x), bf_lo(raw.y), bf_hi(raw.y), bf_lo(raw.z), bf_hi(raw.z), bf_lo(raw.w), bf_hi(raw.w)};
            float ss = 0.f;
#pragma unroll
            for (int e = 0; e < 8; ++e) ss += v[e] * v[e];
            ss += __shfl_xor(ss, 1); ss += __shfl_xor(ss, 2); ss += __shfl_xor(ss, 4); ss += __shfl_xor(ss, 8);
            const float rstd = 1.0f / sqrtf(ss * (1.0f / HD) + EPS);
            const f32x4 g0 = isq ? gq0 : gk0, g1 = isq ? gq1 : gk1;
            v[0] *= rstd * g0.x; v[1] *= rstd * g0.y; v[2] *= rstd * g0.z; v[3] *= rstd * g0.w; v[4] *= rstd * g1.x; v[5] *= rstd * g1.y; v[6] *= rstd * g1.z; v[7] *= rstd * g1.w;
            if (pos >= 0) { const int idx = (l16 < 8) ? (pos >> 6) : (pos & 63); const int j0 = (4 * l16) & 31;
#pragma unroll
                for (int e = 0; e < 4; ++e) { const f32x2 cs = tab[idx * 32 + j0 + e]; const float x1 = v[2 * e], x2 = v[2 * e + 1]; v[2 * e] = x1 * cs.x - x2 * cs.y; v[2 * e + 1] = x1 * cs.y + x2 * cs.x; } }
            u32x4 w; w.x = cvt_pk_bf16(v[0], v[1]); w.y = cvt_pk_bf16(v[2], v[3]); w.z = cvt_pk_bf16(v[4], v[5]); w.w = cvt_pk_bf16(v[6], v[7]);
            *(u32x4*)(dst + 8 * l16) = w;
        }
        for (int row = gw; row < NB * FW; row += NGW) {
            const bf16_t* ur = ut + (size_t)row * SEQ; bf16_t* er = et + (size_t)row * 2048; bf16_t* orow = ot + (size_t)row * 2048;
#pragma unroll
            for (int j = 0; j < 4; ++j) { const int n0 = 8 * (lane_ + 64 * j);
                const u32x4 a = *(const u32x4*)(ur + n0), bq = *(const u32x4*)(ur + SEQ - n0 - 8);
                const float f0 = n0 ? __uint_as_float((unsigned)ur[SEQ - n0] << 16) : 0.f;
                const float av[8] = {bf_lo(a.x), bf_hi(a.x), bf_lo(a.y), bf_hi(a.y), bf_lo(a.z), bf_hi(a.z), bf_lo(a.w), bf_hi(a.w)};
                const float bv[8] = {f0, bf_hi(bq.w), bf_lo(bq.w), bf_hi(bq.z), bf_lo(bq.z), bf_hi(bq.y), bf_lo(bq.y), bf_hi(bq.x)};
                float ev[8], ov[8];
#pragma unroll
                for (int e = 0; e < 8; ++e) { ev[e] = av[e] + bv[e]; ov[e] = av[e] - bv[e]; }
                if (n0 == 0) ov[0] = 0.f;
                u32x4 we, wo; we.x = cvt_pk_bf16(ev[0], ev[1]); we.y = cvt_pk_bf16(ev[2], ev[3]); we.z = cvt_pk_bf16(ev[4], ev[5]); we.w = cvt_pk_bf16(ev[6], ev[7]);
                wo.x = cvt_pk_bf16(ov[0], ov[1]); wo.y = cvt_pk_bf16(ov[2], ov[3]); wo.z = cvt_pk_bf16(ov[4], ov[5]); wo.w = cvt_pk_bf16(ov[6], ov[7]);
                *(u32x4*)(er + n0) = we; *(u32x4*)(orow + n0) = wo; }
        }
        __syncthreads();
    }
    SEAM(3);

    if (IN(4)) {
        {
            const bool x8 = (F.G % 8) == 0; const int per = x8 ? F.G / 8 : F.G;
            for (int i = 0;; ++i) {
                int u;
                if (x8) { const int xcd = F.bid & 7, j = F.bid >> 3, idx = i * per + j; if (idx >= 64) break; u = xcd * 64 + idx; }
                else { u = i * F.G + F.bid; if (u >= 512) break; }
                const int bk = u >> 6, idx = u & 63, b = bk >> 2, kvh = bk & 3, h = kvh * 4 + (idx >> 4), qblk = idx & 15;
                const att::bf16* Qp = (const att::bf16*)qb + (size_t)(b * SEQ + qblk * 256) * DM + h * HD;
                const att::bf16* Kp = (const att::bf16*)kall + (size_t)(b * SKV) * KVW + kvh * HD;
                const att::bf16* Vp = (const att::bf16*)vall + (size_t)(b * SKV) * KVW + kvh * HD;
                att::bf16* Op = (att::bf16*)ob + (size_t)(b * SEQ + qblk * 256) * DM + h * HD;
                att::attn_dense_body(Qp, Kp, Vp, Op, SKV, (char*)lds_raw, F.wave);
            }
        }
        __syncthreads();
        { SchedDft S{F.G, F.bid}; ProbDft P{(const char*)csn, (const char*)et, (const char*)ot}; EpiDft E{zcat, ut};
          pg8::gemm_phase<EpiDft, SchedDft, ProbDft>(F.lds, F.wave, 2048, S, P, E); }
    }
    SEAM(4);

    if (IN(5)) {
        SchedMerge S{F.G, F.bid}; ProbMerge P{(const char*)ob, (const char*)zcat, (const char*)woT, (const char*)wfpT}; EpiMerge E{gbuf, t1, tb};
        pg8::gemm_phase<EpiMerge, SchedMerge, ProbMerge>(F.lds, F.wave, 2048, S, P, E);
    }
    SEAM(5);

    if (IN(6)) {
        SchedN8 S{F.G, F.bid}; ProbPlain P{(const char*)tb, (const char*)woutT, (size_t)256 * 2048 * 2}; EpiRes E{args.in[I_X], args.out, mod + 2 * DM};
        pg8::gemm_phase<EpiRes, SchedN8, ProbPlain>(F.lds, F.wave, 2048, S, P, E);
    }
    SEAM(6);

    if (IN(7)) { PHASE_IDS();
        for (int it = gw; it < 2048; it += NGW) { const int r0 = it * 4, b = r0 / SEQ; const float* mb = mod + (size_t)b * (NMOD * DM);
            norm_mod_rows(args.out, xn, args.in[I_N2G], mb + 4 * DM, mb + 3 * DM, r0, 4, lane_); }
        __syncthreads();
    }
    SEAM(7);

    if (IN(8)) {
        SchedUp S{F.G, F.bid}; ProbPlain P{(const char*)xn, (const char*)w1T, (size_t)256 * 2048 * 2}; EpiUp E{hb};
        pg8::gemm_phase<EpiUp, SchedUp, ProbPlain>(F.lds, F.wave, 2048, S, P, E);
    }
    SEAM(8);

    if (IN(9)) {
        SchedN8 S{F.G, F.bid}; ProbPlain P{(const char*)hb, (const char*)w2T, (size_t)256 * 8192 * 2}; EpiRes E{args.out, args.out, mod + 5 * DM};
        pg8::gemm_phase<EpiRes, SchedN8, ProbPlain>(F.lds, F.wave, 8192, S, P, E);
    }
    SEAM(9);

    if (IN(10)) { PHASE_IDS();
        const float* fg = args.in[I_FNG];
        f32x4 A[8];
#pragma unroll
        for (int j = 0; j < 8; ++j) A[j] = *(const f32x4*)(fg + 4 * lane_ + 256 * j);
        for (int r = gw; r < MTOK; r += NGW) {
            f32x4* xr = (f32x4*)(args.out + (size_t)r * DM) + lane_;
            f32x4 v[8]; float ss = 0.f;
#pragma unroll
            for (int j = 0; j < 8; ++j) { v[j] = xr[64 * j]; ss += (v[j].x * v[j].x + v[j].y * v[j].y) + (v[j].z * v[j].z + v[j].w * v[j].w); }
            const float rstd = 1.0f / sqrtf(wave_sum(ss) * (1.0f / DM) + EPS);
#pragma unroll
            for (int j = 0; j < 8; ++j) xr[64 * j] = v[j] * rstd * A[j];
        }
    }
#undef IN
#undef SEAM
}

extern "C" void kernel_launch(void* const* d_in, const int* in_sizes, int n_in, void* d_out, int out_size, void* d_ws, size_t ws_size, hipStream_t stream) {
    static int grid = 0;
    if (grid == 0) {
        if (n_in != 17 || in_sizes[0] != MTOK * DM || out_size != MTOK * DM || ws_size < WS_END) {
            fprintf(stderr, "kernel_launch: shape/workspace mismatch: n_in %d in0 %d out %d ws %zu (need %zu)\n", n_in, n_in > 0 ? in_sizes[0] : -1, out_size, ws_size, (size_t)WS_END); grid = -1; return; }
        int dev = 0, cus = 0, per_cu = 0;
        hipGetDevice(&dev); hipDeviceGetAttribute(&cus, hipDeviceAttributeMultiprocessorCount, dev);
        if (hipFuncSetAttribute((const void*)fwd_kernel<true>, hipFuncAttributeMaxDynamicSharedMemorySize, LDS_BYTES) != hipSuccess) fprintf(stderr, "kernel_launch: hipFuncSetAttribute(coop) failed\n");
        if (hipFuncSetAttribute((const void*)fwd_kernel<false>, hipFuncAttributeMaxDynamicSharedMemorySize, LDS_BYTES) != hipSuccess) fprintf(stderr, "kernel_launch: hipFuncSetAttribute(plain) failed\n");
        if (hipOccupancyMaxActiveBlocksPerMultiprocessor(&per_cu, (const void*)fwd_kernel<true>, 512, LDS_BYTES) != hipSuccess || per_cu < 1) { fprintf(stderr, "kernel_launch: occupancy query says %d blocks per CU\n", per_cu); per_cu = 1; }
        (void)hipGetLastError();
        grid = cus;
        fprintf(stderr, "kernel_launch: grid %d (cus %d, per_cu %d)\n", grid, cus, per_cu);
    }
    if (grid < 0) return;
    Args a{};
    for (int i = 0; i < 17; ++i) a.in[i] = (const float*)d_in[i];
    a.out = (float*)d_out; a.ws = (unsigned char*)d_ws;
#if MK_COOP
    a.ph_lo = 0; a.ph_hi = N_PHASES;
    void* kargs[] = {&a};
    hipError_t e = hipLaunchCooperativeKernel((const void*)fwd_kernel<true>, dim3(grid), dim3(512), kargs, LDS_BYTES, stream);
    if (e != hipSuccess) fprintf(stderr, "kernel_launch: cooperative launch failed: %s (grid %d)\n", hipGetErrorString(e), grid);
#else
    for (int p = 0; p < N_PHASES; ++p) { a.ph_lo = p; a.ph_hi = p + 1; hipLaunchKernelGGL(fwd_kernel<false>, dim3(grid), dim3(512), LDS_BYTES, stream, a); }
    const hipError_t le = hipPeekAtLastError();
    if (le != hipSuccess) fprintf(stderr, "kernel_launch: launch failed: %s\n", hipGetErrorName(le));
#endif
}
```

```cpp
#include <hip/hip_runtime.h>
#include <hip/hip_cooperative_groups.h>
#include <hip/hip_bf16.h>
#include <cstdio>
#include <cstdint>
namespace cg = cooperative_groups;

#ifndef MK_COOP
#define MK_COOP 1
#endif

#ifndef PROBE_REP
#define PROBE_REP (-1)
#endif
#ifndef PROBE_BARS
#define PROBE_BARS (0)
#endif
#define LAS __attribute__((address_space(3)))
typedef unsigned short bf16_t;
typedef short bf16x8 __attribute__((ext_vector_type(8)));
typedef float f32x4 __attribute__((ext_vector_type(4)));
typedef float f32x2 __attribute__((ext_vector_type(2)));
typedef unsigned u32x4 __attribute__((ext_vector_type(4)));
typedef unsigned u32x2 __attribute__((ext_vector_type(2)));

constexpr int DM = 2048, NB = 2, SEQ = 4096, MTOK = NB * SEQ, CTXL = 256, NCTX = NB * CTXL;
constexpr int HD = 128, NQH = 16, NKVH = 4, KVW = 512, FW = 1024, INW = 8192, DFF = 8192, NMOD = 6;
constexpr int SKV = SEQ + CTXL;
constexpr float EPS = 1e-6f;

constexpr size_t MiB = 1u << 20;
constexpr size_t WS_MOD = 0;
constexpr size_t WS_TS = 176 * 1024;
constexpr size_t WS_BAR = 192 * 1024;
constexpr size_t WS_CSD = 256 * 1024;
constexpr size_t WS_KCRAW = 512 * 1024;
constexpr size_t WS_WIN = 1 * MiB;
constexpr size_t WS_WO = 33 * MiB;
constexpr size_t WS_WFG = 41 * MiB;
constexpr size_t WS_WOUT = 45 * MiB;
constexpr size_t WS_WFP = 53 * MiB;
constexpr size_t WS_CSN = 61 * MiB;
constexpr size_t WS_W1 = 93 * MiB;
constexpr size_t WS_W2 = 329 * MiB;
constexpr size_t WS_ET = 361 * MiB;
constexpr size_t WS_OT = 369 * MiB;
constexpr size_t WS_XN = 125 * MiB;
constexpr size_t WS_G = 159 * MiB;
constexpr size_t WS_Q = 223 * MiB;
constexpr size_t WS_O = 255 * MiB;
constexpr size_t WS_HB = 159 * MiB;
constexpr size_t WS_KRAW = 287 * MiB;
constexpr size_t WS_KALL = 295 * MiB;
constexpr size_t WS_VALL = 304 * MiB;
constexpr size_t WS_UT = 313 * MiB;
constexpr size_t WS_END = 377 * MiB;

constexpr int LDS_BYTES = 131072 + 1024;

__device__ __forceinline__ unsigned cvt_pk_bf16(float lo, float hi) { unsigned r; asm volatile("v_cvt_pk_bf16_f32 %0, %1, %2" : "=v"(r) : "v"(lo), "v"(hi)); return r; }
__device__ __forceinline__ float bf_lo(unsigned w) { return __uint_as_float(w << 16); }
__device__ __forceinline__ float bf_hi(unsigned w) { return __uint_as_float(w & 0xffff0000u); }
__device__ __forceinline__ float sigmoidf_(float v) { return 1.0f / (1.0f + __expf(-v)); }
__device__ __forceinline__ float wave_sum(float v) {
#pragma unroll
    for (int o = 1; o < 64; o <<= 1) v += __shfl_xor(v, o);
    return v;
}

__device__ __forceinline__ int lane_now() { int l; asm volatile("v_mbcnt_lo_u32_b32 %0, -1, 0\n\tv_mbcnt_hi_u32_b32 %0, -1, %0" : "=v"(l)); return l; }

namespace pg8 {
constexpr int BM = 256, BK = 64, HALF = 128, HTB = HALF * BK * 2, STAGE_BYTES = 8 * HTB, NXCD = 8, WGM = 8;
__host__ __device__ __forceinline__ int lds_byte(int r, int c) { const int st = (r >> 4) * 2 + (c >> 5), rr = r & 15, cc = c & 31, ob = rr * 64 + cc * 2; return st * 1024 + (ob ^ (((ob >> 9) & 1) << 5)); }
__host__ __device__ __forceinline__ void stage_rc(int b, int& R, int& C) { const int st = b / 1024, sb = b % 1024, swz = sb ^ (((sb >> 9) & 1) << 5); R = (st >> 1) * 16 + swz / 64; C = (st & 1) * 32 + (swz % 64) / 2; }
__host__ __device__ __forceinline__ int perm32(int rho) { const int n = rho >> 4, i = rho & 15; return 8 * (i >> 2) + 4 * n + (i & 3); }

struct Unit { int pm, pn, kind, aux; };

__device__ __forceinline__ void tile_map(int L, int nM, int nN, int& pm, int& pn) {
    const int nwg = nM * nN; int wgid = L;
    { const int q = nwg / NXCD, r = nwg % NXCD, xcd = wgid % NXCD, off = wgid / NXCD; wgid = (xcd < r ? xcd * (q + 1) : r * (q + 1) + (xcd - r) * q) + off; }
    const int nig = WGM * nN, gid = wgid / nig, fm = gid * WGM, gsz = (nM - fm) < WGM ? (nM - fm) : WGM;
    pm = fm + ((wgid % nig) % gsz); pn = (wgid % nig) / gsz;
}

template <class Epi, class Sched, class Prob>
__device__ __forceinline__ void gemm_phase(LAS unsigned char* lds, const int wid, const int K, const Sched& S, const Prob& P, const Epi& E) {
    const int lane = lane_now(), tid = wid * 64 + lane, wr = wid >> 2, wc = wid & 3;
    const int nt = K / BK;
    unsigned voffA[2], voffB[2];
#pragma unroll
    for (int i = 0; i < 2; ++i) { int R, C; stage_rc(tid * 16 + i * 8192, R, C); const int Rb = (R & ~31) + perm32(R & 31);
        voffA[i] = (unsigned)(R * K + C) * 2u; voffB[i] = (unsigned)(Rb * K + C) * 2u; }
    const size_t kstep = (size_t)(BK * 2);
    const size_t hstep = (size_t)HALF * K * 2;
    const unsigned ldsw = (unsigned)wid * 1024u;
    const int aoff = lds_byte(wr * 64 + (lane & 15), (lane >> 4) * 8), boff = lds_byte(wc * 32 + (lane & 15), (lane >> 4) * 8);
#define PG8_SA(b, h) (((b) * 2 + (h)) * HTB)
#define PG8_SB(b, h) ((4 + (b) * 2 + (h)) * HTB)
#define PG8_STAGE(bufoff, gbase, voff) do { _Pragma("unroll") for (int _i = 0; _i < 2; ++_i) \
        __builtin_amdgcn_global_load_lds((const unsigned*)((const char*)(gbase) + (voff)[_i]), (LAS unsigned*)(lds + (bufoff) + ldsw + _i * 8192), 16, 0, 0); } while (0)
#define PG8_LDA(dst, b, h) do { _Pragma("unroll") for (int m = 0; m < 4; ++m) _Pragma("unroll") for (int k = 0; k < 2; ++k) dst[m][k] = *(const LAS bf16x8*)(lds + PG8_SA(b, h) + aoff + m * 2048 + k * 1024); } while (0)
#define PG8_LDB(dst, b, h) do { _Pragma("unroll") for (int n = 0; n < 2; ++n) _Pragma("unroll") for (int k = 0; k < 2; ++k) dst[n][k] = *(const LAS bf16x8*)(lds + PG8_SB(b, h) + boff + n * 2048 + k * 1024); } while (0)
#define PG8_MMA(ai, bj, At, Bt) do { __builtin_amdgcn_s_setprio(1); _Pragma("unroll") for (int m = 0; m < 4; ++m) _Pragma("unroll") for (int n = 0; n < 2; ++n) _Pragma("unroll") for (int k = 0; k < 2; ++k) \
        acc[ai][bj][m][n] = __builtin_amdgcn_mfma_f32_16x16x32_bf16(Bt[n][k], At[m][k], acc[ai][bj][m][n], 0, 0, 0); __builtin_amdgcn_s_setprio(0); } while (0)
#define PG8_WAIT_V(n) asm volatile("s_waitcnt vmcnt(" #n ")" ::: "memory")
#define PG8_WAIT_L(n) asm volatile("s_waitcnt lgkmcnt(" #n ")" ::: "memory")
#define PG8_BAR __builtin_amdgcn_s_barrier()
#define PG8_SCHED __builtin_amdgcn_sched_barrier(0)
    Unit cur, nxt; int ui = 0;
    if (!S.next(0, cur)) return;
    f32x4 acc[2][2][4][2];
#pragma unroll
    for (int a = 0; a < 2; ++a)
#pragma unroll
        for (int b = 0; b < 2; ++b)
#pragma unroll
            for (int m = 0; m < 4; ++m)
#pragma unroll
                for (int n = 0; n < 2; ++n) acc[a][b][m][n] = (f32x4){0.f, 0.f, 0.f, 0.f};
    bf16x8 At[4][2], B0[2][2], B1[2][2];
    const char* cA = P.A(cur); const char* cB = P.B(cur);
    PG8_STAGE(PG8_SB(0, 0), cB, voffB); PG8_STAGE(PG8_SB(0, 1), cB + hstep, voffB); PG8_STAGE(PG8_SA(0, 0), cA, voffA); PG8_STAGE(PG8_SA(0, 1), cA + hstep, voffA);
    if (wr == 1) PG8_BAR;
    PG8_WAIT_V(2); PG8_BAR;
    PG8_STAGE(PG8_SB(1, 0), cB + kstep, voffB); PG8_STAGE(PG8_SA(1, 0), cA + kstep, voffA); PG8_STAGE(PG8_SB(1, 1), cB + hstep + kstep, voffB);
    PG8_WAIT_V(6); PG8_BAR;
    for (;;) {
        const bool has_next = S.next(ui + 1, nxt);
        const char* nA = has_next ? P.A(nxt) : cA; const char* nB = has_next ? P.B(nxt) : cB;
        for (int t = 0; t < nt; t += 2) {
            const bool last = (t == nt - 2);
            const char* a1 = cA + (size_t)(t + 1) * kstep;
            const char* a2 = last ? nA : cA + (size_t)(t + 2) * kstep; const char* b2 = last ? nB : cB + (size_t)(t + 2) * kstep;
            const char* a3 = a2 + kstep; const char* b3 = b2 + kstep;
            PG8_LDB(B0, 0, 0); PG8_LDB(B1, 0, 1); PG8_SCHED; PG8_LDA(At, 0, 0); PG8_STAGE(PG8_SA(1, 1), a1 + hstep, voffA);
            PG8_WAIT_V(8); PG8_WAIT_L(0); PG8_BAR; PG8_MMA(0, 0, At, B0); PG8_MMA(0, 1, At, B1); PG8_BAR; PG8_SCHED;
            PG8_LDA(At, 0, 1); PG8_STAGE(PG8_SB(0, 0), b2, voffB); PG8_STAGE(PG8_SB(0, 1), b2 + hstep, voffB); PG8_STAGE(PG8_SA(0, 0), a2, voffA);
            PG8_WAIT_V(8); PG8_WAIT_L(0); PG8_BAR; PG8_MMA(1, 0, At, B0); PG8_MMA(1, 1, At, B1); PG8_BAR; PG8_SCHED;
            PG8_LDB(B0, 1, 0); PG8_LDB(B1, 1, 1); PG8_SCHED; PG8_LDA(At, 1, 0); PG8_STAGE(PG8_SA(0, 1), a2 + hstep, voffA);
            PG8_WAIT_V(8); PG8_WAIT_L(0); PG8_BAR; PG8_MMA(0, 0, At, B0); PG8_MMA(0, 1, At, B1); PG8_BAR; PG8_SCHED;
            PG8_LDA(At, 1, 1); PG8_STAGE(PG8_SB(1, 0), b3, voffB); PG8_STAGE(PG8_SB(1, 1), b3 + hstep, voffB); PG8_STAGE(PG8_SA(1, 0), a3, voffA);
            PG8_WAIT_V(8); PG8_WAIT_L(0); PG8_BAR; PG8_MMA(1, 0, At, B0); PG8_MMA(1, 1, At, B1); PG8_BAR; PG8_SCHED;
        }
        if (wr == 0) PG8_BAR;
        { const int l2 = lane_now(); E(acc, cur, wr, wc, l2 & 15, l2 >> 4); }
        if (!has_next) break;
#pragma unroll
        for (int a = 0; a < 2; ++a)
#pragma unroll
            for (int b = 0; b < 2; ++b)
#pragma unroll
                for (int m = 0; m < 4; ++m)
#pragma unroll
                    for (int n = 0; n < 2; ++n) acc[a][b][m][n] = (f32x4){0.f, 0.f, 0.f, 0.f};
        cur = nxt; cA = nA; cB = nB; ++ui;
        if (wr == 1) PG8_BAR;
    }
    PG8_WAIT_V(0);
    PG8_BAR;
#undef PG8_SA
#undef PG8_SB
#undef PG8_STAGE
#undef PG8_LDA
#undef PG8_LDB
#undef PG8_MMA
#undef PG8_WAIT_V
#undef PG8_WAIT_L
#undef PG8_BAR
#undef PG8_SCHED
}

__device__ __forceinline__ void store_tile_bf16(const f32x4 (&acc)[2][2][4][2], bf16_t* dst, size_t pitch, float sc, int wr, int wc, int fr, int fq) {
    asm volatile("" : "+v"(fr), "+v"(fq));
    const unsigned lo = (unsigned)(wr * 64 + fr) * (unsigned)pitch + (unsigned)(wc * 32 + 8 * fq);
#pragma unroll
    for (int ai = 0; ai < 2; ++ai)
#pragma unroll
        for (int m = 0; m < 4; ++m) { bf16_t* rowu = dst + (size_t)(ai * HALF + m * 16) * pitch;
#pragma unroll
            for (int bj = 0; bj < 2; ++bj) { const f32x4 v0 = acc[ai][bj][m][0] * sc, v1 = acc[ai][bj][m][1] * sc;
                u32x4 w; w.x = cvt_pk_bf16(v0[0], v0[1]); w.y = cvt_pk_bf16(v0[2], v0[3]); w.z = cvt_pk_bf16(v1[0], v1[1]); w.w = cvt_pk_bf16(v1[2], v1[3]);
                *(u32x4*)(rowu + bj * HALF + lo) = w; } }
}
}

namespace att {
using bf16 = __hip_bfloat16;
constexpr int D = 128, NW = 8, QBLK = 32, KVBLK = 64;
constexpr float SCALE = 0.088388347648318440f;
constexpr float THR = 8.f;
constexpr int LDQ = DM, LDK = KVW, LDO = DM;
constexpr size_t SHM_V = KVBLK * D * 2, SHM_K = KVBLK * D * 2, SHM_ATTN = 2 * SHM_V + 2 * SHM_K + NW * 64 * 4;
using s16x4 = __attribute__((ext_vector_type(4))) short;
using f32x16 = __attribute__((ext_vector_type(16))) float;
#define KSWZ(row, colB) ((row) * 256 + ((colB) ^ (((row) & 7) << 4)))
#define SBAR() __builtin_amdgcn_sched_barrier(0)
__device__ __forceinline__ int crow(int r, int hi) { return (r & 3) + 8 * (r >> 2) + 4 * hi; }
__device__ __forceinline__ unsigned cvtpk(float lo, float hi) { unsigned r; asm volatile("v_cvt_pk_bf16_f32 %0, %1, %2" : "=v"(r) : "v"(lo), "v"(hi)); return r; }
__device__ __forceinline__ void partialSM(f32x16& p0, f32x16& p1, float& m_reg, float& mn, float& alpha) {
  constexpr float C = SCALE * 1.4426950408889634f;
  float pmax = p0[0]; for (int r = 1; r < 16; ++r) pmax = fmaxf(pmax, p0[r]); for (int r = 0; r < 16; ++r) pmax = fmaxf(pmax, p1[r]);
  { auto rr = __builtin_amdgcn_permlane32_swap(__float_as_uint(pmax), __float_as_uint(pmax), false, false);
    pmax = fmaxf(__uint_as_float(rr[0]), __uint_as_float(rr[1])); }
  if (__builtin_expect(__all(pmax - m_reg <= THR / SCALE), 1)) { mn = m_reg; alpha = 1.f; }
  else { mn = fmaxf(m_reg, pmax); alpha = __builtin_amdgcn_exp2f((m_reg - mn) * C); m_reg = mn; }
  float mnC = -mn * C;
  for (int r = 0; r < 16; ++r) p0[r] = fmaf(p0[r], C, mnC); for (int r = 0; r < 16; ++r) p1[r] = fmaf(p1[r], C, mnC);
  for (int r = 0; r < 16; ++r) p0[r] = __builtin_amdgcn_exp2f(p0[r]);
}
__device__ __forceinline__ void finishSM(f32x16& p0, f32x16& p1, float alpha, float& l_reg, bf16x8& pa0, bf16x8& pa1, bf16x8& pa2, bf16x8& pa3) {
  for (int r = 0; r < 16; ++r) p1[r] = __builtin_amdgcn_exp2f(p1[r]);
  float ps = 0; for (int r = 0; r < 16; ++r) ps += p0[r]; for (int r = 0; r < 16; ++r) ps += p1[r];
  { auto rr = __builtin_amdgcn_permlane32_swap(__float_as_uint(ps), __float_as_uint(ps), false, false);
    ps = __uint_as_float(rr[0]) + __uint_as_float(rr[1]); }
  l_reg = l_reg * alpha + ps;
#define PK4(P, BASE, OUT) do { unsigned a0 = cvtpk(P[BASE + 0], P[BASE + 1]), a1 = cvtpk(P[BASE + 2], P[BASE + 3]);   \
    unsigned b0 = cvtpk(P[BASE + 4], P[BASE + 5]), b1 = cvtpk(P[BASE + 6], P[BASE + 7]);                              \
    auto r0 = __builtin_amdgcn_permlane32_swap(a0, b0, false, false); auto r1 = __builtin_amdgcn_permlane32_swap(a1, b1, false, false); \
    u32x4 w = {r0[0], r1[0], r0[1], r1[1]}; OUT = *reinterpret_cast<bf16x8*>(&w); } while (0)
  PK4(p0, 0, pa0); PK4(p0, 8, pa1); PK4(p1, 0, pa2); PK4(p1, 8, pa3);
#undef PK4
}
__device__ __forceinline__ void qkt(f32x16& p0, f32x16& p1, const bf16* Ks, const bf16x8* qr, int r32, int hi) {
  p0 = f32x16{}; p1 = f32x16{};
  for (int d0 = 0; d0 < 8; ++d0) { int cb = (d0 * 16 + hi * 8) * 2;
    bf16x8 b0 = *reinterpret_cast<const bf16x8*>((const char*)Ks + KSWZ(r32, cb));
    bf16x8 b1 = *reinterpret_cast<const bf16x8*>((const char*)Ks + KSWZ(32 + r32, cb));
    p0 = __builtin_amdgcn_mfma_f32_32x32x16_bf16(b0, qr[d0], p0, 0, 0, 0);
    p1 = __builtin_amdgcn_mfma_f32_32x32x16_bf16(b1, qr[d0], p1, 0, 0, 0); }
}
__device__ __forceinline__ int v_st(int k, int c) { const int kk = (k & ~0xC) | ((k & 4) << 1) | ((k & 8) >> 1); return ((kk >> 3) * 4 + (c >> 5)) * 512 + ((kk & 7) * 32 + (c & 31)) * 2; }
__device__ __forceinline__ int v_rd_base(int lane) { return ((lane & 3) << 3) | (((lane >> 2) & 3) << 6) | (((lane >> 4) & 1) << 5) | (((lane >> 5) & 1) << 8); }
constexpr int v_rd_off(int d0, int ks, int half) { return d0 * 512 + ks * 4096 + half * 2048; }
template <int OFF> __device__ __forceinline__ s16x4 tr_read(int vb) {
  s16x4 r; asm volatile("ds_read_b64_tr_b16 %0, %1 offset:%2" : "=&v"(r) : "v"(vb), "i"(OFF) : "memory"); return r;
}
template <int D0> __device__ __forceinline__ void pv_one(f32x16& od, int vb, bf16x8 pa0, bf16x8 pa1, bf16x8 pa2, bf16x8 pa3) {
  const s16x4 l0 = tr_read<v_rd_off(D0, 0, 0)>(vb), h0 = tr_read<v_rd_off(D0, 0, 1)>(vb), l1 = tr_read<v_rd_off(D0, 1, 0)>(vb), h1 = tr_read<v_rd_off(D0, 1, 1)>(vb);
  const s16x4 l2 = tr_read<v_rd_off(D0, 2, 0)>(vb), h2 = tr_read<v_rd_off(D0, 2, 1)>(vb), l3 = tr_read<v_rd_off(D0, 3, 0)>(vb), h3 = tr_read<v_rd_off(D0, 3, 1)>(vb);
  asm volatile("s_waitcnt lgkmcnt(0)" ::: "memory"); SBAR();
#define PK(L, H) (bf16x8){L[0], L[1], L[2], L[3], H[0], H[1], H[2], H[3]}
  od = __builtin_amdgcn_mfma_f32_32x32x16_bf16(pa0, PK(l0, h0), od, 0, 0, 0);
  od = __builtin_amdgcn_mfma_f32_32x32x16_bf16(pa1, PK(l1, h1), od, 0, 0, 0);
  od = __builtin_amdgcn_mfma_f32_32x32x16_bf16(pa2, PK(l2, h2), od, 0, 0, 0);
  od = __builtin_amdgcn_mfma_f32_32x32x16_bf16(pa3, PK(l3, h3), od, 0, 0, 0);
#undef PK
}
__device__ __forceinline__ void pv_d0(f32x16* o, int vb, bf16x8 pa0, bf16x8 pa1, bf16x8 pa2, bf16x8 pa3) {
  pv_one<0>(o[0], vb, pa0, pa1, pa2, pa3); pv_one<1>(o[1], vb, pa0, pa1, pa2, pa3); pv_one<2>(o[2], vb, pa0, pa1, pa2, pa3); pv_one<3>(o[3], vb, pa0, pa1, pa2, pa3);
}

__device__ __forceinline__ void attn_dense_body(const bf16* __restrict__ Qb, const bf16* __restrict__ Kh, const bf16* __restrict__ Vh,
                                                bf16* __restrict__ Ob, int seq, char* lds, const int wid) {
  const int lane = lane_now(), tid = wid * 64 + lane, r32 = lane & 31, hi = lane >> 5;
  bf16* V_lds = (bf16*)lds; bf16* K_lds = (bf16*)(lds + 2 * SHM_V);
  float* ws = (float*)(lds + 2 * SHM_V + 2 * SHM_K) + wid * 64; float* li_l = ws; float* al_l = ws + 32;
  float m_reg = -1e30f, l_reg = 0; f32x16 o[4] = {}; bf16x8 qr[8];
  const bf16* Qw = Qb + (long)(wid * QBLK + r32) * LDQ + hi * 8;
#pragma unroll
  for (int d0 = 0; d0 < 8; ++d0) qr[d0] = *reinterpret_cast<const bf16x8*>(Qw + d0 * 16);
  const int sr = tid >> 4, sc = (tid & 15) * 8, vst0 = v_st(sr, sc), vst1 = v_st(32 + sr, sc);
  const int vb0 = (int)(uintptr_t)V_lds + v_rd_base(lane);
  struct { bf16x8 vs0, vs1, ks0, ks1; } sr_[2];
#define SLOAD(i, k0) do { sr_[i].vs0 = *reinterpret_cast<const bf16x8*>(&Vh[(long)((k0) + sr) * LDK + sc]); sr_[i].vs1 = *reinterpret_cast<const bf16x8*>(&Vh[(long)((k0) + 32 + sr) * LDK + sc]); \
    sr_[i].ks0 = *reinterpret_cast<const bf16x8*>(&Kh[(long)((k0) + sr) * LDK + sc]); sr_[i].ks1 = *reinterpret_cast<const bf16x8*>(&Kh[(long)((k0) + 32 + sr) * LDK + sc]); } while (0)
#define SWRITE(b, i) do { *(bf16x8*)((char*)V_lds + (b) * SHM_V + vst0) = sr_[i].vs0;          \
    *(bf16x8*)((char*)V_lds + (b) * SHM_V + vst1) = sr_[i].vs1; int kc = sc * 2;               \
    *(bf16x8*)((char*)K_lds + (b) * SHM_K + KSWZ(sr, kc)) = sr_[i].ks0;                       \
    *(bf16x8*)((char*)K_lds + (b) * SHM_K + KSWZ(32 + sr, kc)) = sr_[i].ks1; } while (0)
#define SWAIT() asm volatile("s_waitcnt vmcnt(4)" ::: "memory")
#define RESC(a) do { if (__any((a) < 1.f)) { if (hi == 0) al_l[r32] = (a); asm volatile("s_waitcnt lgkmcnt(0)" ::: "memory"); \
    for (int d = 0; d < 4; ++d) for (int r = 0; r < 16; ++r) o[d][r] *= al_l[crow(r, hi)]; } } while (0)
  f32x16 pA0, pA1, pB0, pB1; float mnA, mnB, alA, alB; bf16x8 pa0, pa1, pa2, pa3; const int NT = seq / KVBLK;
  constexpr int SE = 0, SO = 1;
  SLOAD(SE, 0); asm volatile("s_waitcnt vmcnt(0)" ::: "memory"); SWRITE(0, SE); __syncthreads();
  qkt(pA0, pA1, K_lds, qr, r32, hi); partialSM(pA0, pA1, m_reg, mnA, alA);
  SLOAD(SO, KVBLK); if (2 < NT) SLOAD(SE, 2 * KVBLK);
  SWAIT(); SWRITE(1, SO); __syncthreads();
  for (int j = 1; j + 1 < NT; j += 2) {
    SBAR(); qkt(pB0, pB1, (bf16*)((char*)K_lds + SHM_K), qr, r32, hi);
    finishSM(pA0, pA1, alA, l_reg, pa0, pa1, pa2, pa3); SBAR();
    SLOAD(SO, (j + 2) * KVBLK); SBAR();
    pv_d0(o, vb0, pa0, pa1, pa2, pa3); partialSM(pB0, pB1, m_reg, mnB, alB);
    __syncthreads(); SWAIT(); SWRITE(0, SE);
    RESC(alB); __syncthreads();
    SBAR(); qkt(pA0, pA1, K_lds, qr, r32, hi);
    finishSM(pB0, pB1, alB, l_reg, pa0, pa1, pa2, pa3); SBAR();
    if (j + 3 < NT) SLOAD(SE, (j + 3) * KVBLK); SBAR();
    pv_d0(o, vb0 + (int)SHM_V, pa0, pa1, pa2, pa3); partialSM(pA0, pA1, m_reg, mnA, alA);
    __syncthreads(); SWAIT(); SWRITE(1, SO);
    RESC(alA); __syncthreads();
  }
  SBAR(); qkt(pB0, pB1, (bf16*)((char*)K_lds + SHM_K), qr, r32, hi);
  finishSM(pA0, pA1, alA, l_reg, pa0, pa1, pa2, pa3); SBAR();
  pv_d0(o, vb0, pa0, pa1, pa2, pa3); partialSM(pB0, pB1, m_reg, mnB, alB);
  __syncthreads(); RESC(alB);
  finishSM(pB0, pB1, alB, l_reg, pa0, pa1, pa2, pa3); SBAR();
  pv_d0(o, vb0 + (int)SHM_V, pa0, pa1, pa2, pa3);
  if (hi == 0) li_l[r32] = l_reg; asm volatile("s_waitcnt lgkmcnt(0)" ::: "memory");
  float rli[16];
#pragma unroll
  for (int r = 0; r < 16; ++r) rli[r] = __builtin_amdgcn_rcpf(li_l[crow(r, hi)]);
  bf16* Ow = Ob + (long)(wid * QBLK) * LDO;
#pragma unroll
  for (int r = 0; r < 16; ++r) { int orow = crow(r, hi);
    for (int d0 = 0; d0 < 4; ++d0) Ow[(long)orow * LDO + d0 * 32 + r32] = __float2bfloat16(o[d0][r] * rli[r]); }
  __syncthreads();
#undef SLOAD
#undef SWRITE
#undef SWAIT
#undef RESC
}
#undef KSWZ
#undef SBAR
}

#define XB_TMO      128
#define XB_XCNT(j)  (256  + 64 * (j))
#define XB_XSUB(j)  (1280 + 64 * (j))
#define XB_XGEN(j)  (2304 + 64 * (j))
#define XB_TOP      3328
#define XB_TOPGEN   3392
#define XCD_BAR_WORDS 3456
#define XB_SPIN_CAP (1u << 18)
__device__ __forceinline__ unsigned xb_ld(unsigned* p)              { return __hip_atomic_load(p, __ATOMIC_RELAXED, __HIP_MEMORY_SCOPE_AGENT); }
__device__ __forceinline__ unsigned xb_add(unsigned* p, unsigned v) { return __hip_atomic_fetch_add(p, v, __ATOMIC_RELAXED, __HIP_MEMORY_SCOPE_AGENT); }
__device__ __forceinline__ unsigned xb_xcc_id() { return (unsigned)__builtin_amdgcn_s_getreg((3 << 11) | 20) & 0xFu; }
#define XB_SPIN(cond, bar) do { unsigned _sp = 0; while (cond) { __builtin_amdgcn_s_sleep(1); \
    if ((++_sp & 255u) == 0u) { if (xb_ld(&(bar)[XB_TMO])) break; if (_sp > XB_SPIN_CAP) { atomicAdd(&(bar)[XB_TMO], 1u); break; } } } } while (0)
struct XcdBarrier { unsigned* bar; unsigned x; volatile LAS unsigned* st; };
__device__ __forceinline__ XcdBarrier xcd_barrier_post(unsigned* bar, volatile LAS unsigned* st, int wave) {
    XcdBarrier b; b.bar = bar; b.x = xb_xcc_id(); b.st = st;
    if (wave == 0 && lane_now() == 0) (void)xb_add(&bar[XB_XCNT(b.x)], 1u);
    return b;
}
__device__ __forceinline__ void xcd_barrier_complete(unsigned* bar, unsigned x, unsigned& nloc, unsigned& nx) {
    const unsigned G = gridDim.x * gridDim.y * gridDim.z;
    unsigned sum, cnt, mine, sp = 0u;
    for (;;) {
        sum = 0u; cnt = 0u; mine = 0u;
#pragma unroll
        for (unsigned j = 0; j < 16; ++j) { const unsigned c = xb_ld(&bar[XB_XCNT(j)]); sum += c; cnt += (c > 0u) ? 1u : 0u; mine = (j == x) ? c : mine; }
        if (sum == G) break;
        __builtin_amdgcn_s_sleep(1);
        if ((++sp & 255u) == 0u) { if (xb_ld(&bar[XB_TMO])) break; if (sp > XB_SPIN_CAP) { atomicAdd(&bar[XB_TMO], 1u); break; } }
    }
    nloc = mine > 0u ? mine : 1u; nx = cnt > 0u ? cnt : 1u;
}
__device__ __forceinline__ void xcd_barrier(const XcdBarrier& b, int wave) {
    asm volatile("s_waitcnt vmcnt(0)" ::: "memory");
    __syncthreads();
    if (wave == 0 && lane_now() == 0) {
        unsigned* bar = b.bar;
        __builtin_amdgcn_s_waitcnt(0);
        unsigned nloc = b.st[0], nx = b.st[1];
        if (nloc == 0u) { xcd_barrier_complete(bar, b.x, nloc, nx); b.st[0] = nloc; b.st[1] = nx; }
        const unsigned old = xb_add(&bar[XB_XSUB(b.x)], 1u);
        const unsigned gen = old / nloc;
        if (old + 1u == (gen + 1u) * nloc) {
            __builtin_amdgcn_fence(__ATOMIC_RELEASE, "agent");
            asm volatile("s_waitcnt vmcnt(0)" ::: "memory");
            const unsigned og = xb_add(&bar[XB_TOP], 1u);
            const unsigned tg = og / nx;
            if (og + 1u == (tg + 1u) * nx) xb_add(&bar[XB_TOPGEN], 1u);
            else XB_SPIN(xb_ld(&bar[XB_TOPGEN]) == tg, bar);
            __builtin_amdgcn_fence(__ATOMIC_ACQUIRE, "agent");
            xb_add(&bar[XB_XGEN(b.x)], 1u);
            asm volatile("s_waitcnt vmcnt(0)" ::: "memory");
        } else {
            XB_SPIN(xb_ld(&bar[XB_XGEN(b.x)]) == gen, bar);
            __builtin_amdgcn_fence(__ATOMIC_ACQUIRE, "agent");
            asm volatile("s_waitcnt vmcnt(0)" ::: "memory");
        }
    }
    __syncthreads();
}

struct Args { const float* in[17]; float* out; unsigned char* ws; int ph_lo, ph_hi; };
enum { I_X = 0, I_C, I_CTX, I_CCTX, I_WADA, I_BADA, I_N1G, I_WIN, I_QNG, I_KNG, I_WAO, I_WF, I_WOUT, I_N2G, I_W1, I_W2, I_FNG };

struct Frame {
    LAS unsigned char* lds;
    int wave, G, bid;
};

__device__ __forceinline__ void transpose_item(const float* W, int ldw, int k0, int n0, bf16_t* dst, int dpitch, LAS float* scr, int lane) {
#pragma unroll 8
    for (int i = 0; i < 32; ++i) { const int kk = 2 * i + (lane >> 5); scr[kk * 33 + (lane & 31)] = W[(size_t)(k0 + kk) * ldw + n0 + (lane & 31)]; }
    asm volatile("s_waitcnt lgkmcnt(0)" ::: "memory");
    const int c = lane & 7;
#pragma unroll
    for (int j = 0; j < 4; ++j) { const int n = (lane >> 3) + 8 * j; const LAS float* s = scr + (8 * c) * 33 + n;
        u32x4 o; o.x = cvt_pk_bf16(s[0 * 33], s[1 * 33]); o.y = cvt_pk_bf16(s[2 * 33], s[3 * 33]); o.z = cvt_pk_bf16(s[4 * 33], s[5 * 33]); o.w = cvt_pk_bf16(s[6 * 33], s[7 * 33]);
        *(u32x4*)(dst + (size_t)n * dpitch + 8 * c) = o; }
    asm volatile("s_waitcnt lgkmcnt(0)" ::: "memory");
}

__device__ __forceinline__ void norm_mod_rows(const float* src, bf16_t* dst, const float* gam, const float* sc, const float* sh, int r0, int cnt, int lane) {
    f32x4 A[8], Bv[8];
#pragma unroll
    for (int j = 0; j < 8; ++j) { const int c = 4 * lane + 256 * j; const f32x4 g = *(const f32x4*)(gam + c); const f32x4 s = *(const f32x4*)(sc + c); A[j] = g * (s + 1.0f); Bv[j] = *(const f32x4*)(sh + c); }
    for (int r = r0; r < r0 + cnt; ++r) {
        const f32x4* xr = (const f32x4*)(src + (size_t)r * DM) + lane;
        f32x4 v[8]; float ss = 0.f;
#pragma unroll
        for (int j = 0; j < 8; ++j) { v[j] = xr[64 * j]; ss += (v[j].x * v[j].x + v[j].y * v[j].y) + (v[j].z * v[j].z + v[j].w * v[j].w); }
        const float rstd = 1.0f / sqrtf(wave_sum(ss) * (1.0f / DM) + EPS);
        u32x2* o8 = (u32x2*)(dst + (size_t)r * DM) + lane;
#pragma unroll
        for (int j = 0; j < 8; ++j) { const f32x4 y = v[j] * rstd * A[j] + Bv[j]; u32x2 w; w.x = cvt_pk_bf16(y.x, y.y); w.y = cvt_pk_bf16(y.z, y.w); o8[64 * j] = w; }
    }
}

using pg8::Unit;
struct SchedWfp { int G, c; __device__ bool next(int i, Unit& u) const { const int L = i * G + c; if (L >= 64) return false; u.aux = L >> 4; const int l = L & 15; u.pm = l & 7; u.pn = l >> 3; u.kind = 0; return true; } };
struct ProbWfp { const char* wfg; const char* csd; __device__ const char* A(const Unit& u) const { return wfg + (size_t)u.aux * 2048 * 256 * 2 + (size_t)u.pm * 256 * 256 * 2; } __device__ const char* B(const Unit& u) const { return csd + (size_t)u.pn * 256 * 256 * 2; } };
struct EpiWfp { bf16_t* wfp; __device__ void operator()(const f32x4 (&acc)[2][2][4][2], const Unit& u, int wr, int wc, int fr, int fq) const {
    pg8::store_tile_bf16(acc, wfp + (size_t)(u.pm * 256) * 2048 + u.aux * 512 + u.pn * 256, 2048, 1.0f, wr, wc, fr, fq); } };

struct SchedIn { int G, c; __device__ bool next(int i, Unit& u) const { const int L = i * G + c; if (L >= 1032) return false; u.aux = 0;
    if (L < 896) { u.kind = 0; pg8::tile_map(L, 32, 28, u.pm, u.pn); } else if (L < 1024) { u.kind = 1; pg8::tile_map(L - 896, 4, 32, u.pm, u.pn); } else { u.kind = 2; const int l = L - 1024; u.pm = 32 + (l >> 2); u.pn = 8 + (l & 3); } return true; } };
struct ProbIn { const char* xn; const char* win; static constexpr size_t TS = (size_t)256 * 2048 * 2;
    __device__ const char* A(const Unit& u) const { return (u.kind == 1 ? win + (size_t)7168 * 2048 * 2 : xn) + (size_t)u.pm * TS; }
    __device__ const char* B(const Unit& u) const { return (u.kind == 1 ? xn : win) + (size_t)u.pn * TS; } };
struct EpiIn { bf16_t *q, *kraw, *kcraw, *vall, *g, *ut;
    __device__ void operator()(const f32x4 (&acc)[2][2][4][2], const Unit& u, int wr, int wc, int fr, int fq) const {
        bf16_t* dst; size_t pitch;
        if (u.kind == 1) { dst = ut + (size_t)(u.pn >> 4) * 1024 * 4096 + (size_t)(u.pm * 256) * 4096 + (u.pn & 15) * 256; pitch = 4096; }
        else if (u.pn < 8) { dst = q + (size_t)(u.pm * 256) * 2048 + u.pn * 256; pitch = 2048; }
        else if (u.pn < 10) { dst = (u.kind == 0 ? kraw + (size_t)(u.pm * 256) * 512 : kcraw + (size_t)((u.pm - 32) * 256) * 512) + (u.pn - 8) * 256; pitch = 512; }
        else if (u.pn < 12) { const size_t row = (u.kind == 0) ? (size_t)(u.pm * 256 + (u.pm >> 4) * CTXL) : (size_t)((u.pm - 32) * SKV + SEQ); dst = vall + row * 512 + (u.pn - 10) * 256; pitch = 512; }
        else { dst = g + (size_t)(u.pm * 256) * 4096 + (u.pn - 12) * 256; pitch = 4096; }
        pg8::store_tile_bf16(acc, dst, pitch, 1.0f, wr, wc, fr, fq); } };

struct SchedDft { int G, c; __device__ bool next(int i, Unit& u) const { const int L = i * G + c; if (L >= 256) return false; u.aux = L >> 7; u.kind = 0; pg8::tile_map(L & 127, 32, 4, u.pm, u.pn); return true; } };
struct ProbDft { const char* csn; const char* et; const char* ot; static constexpr size_t TS = (size_t)256 * 2048 * 2;
    __device__ const char* A(const Unit& u) const { return csn + (size_t)u.pm * TS; }
    __device__ const char* B(const Unit& u) const { return ((u.pm >> 4) ? ot : et) + (size_t)u.aux * 1024 * 2048 * 2 + (size_t)u.pn * TS; } };
struct EpiDft { bf16_t* zcat; const bf16_t* ut;
    __device__ void operator()(const f32x4 (&acc)[2][2][4][2], const Unit& u, int wr, int wc, int fr, int fq) const {
        asm volatile("" : "+v"(fr), "+v"(fq));
        const int ri = u.pm >> 4; const float sgn = (fr & 1) ? -1.0f : 1.0f;
        bf16_t* dst = zcat + (size_t)(u.aux * SEQ + (u.pm & 15) * 256) * 2048 + u.pn * 512 + ri * 256;
        const unsigned lcol = (unsigned)(wc * 32 + 8 * fq), lo = (unsigned)(wr * 64 + fr) * 2048u + lcol;
        const bf16_t* um = ut + (size_t)u.aux * 1024 * 4096 + (size_t)(u.pn * 256) * 4096 + 2048;
#pragma unroll
        for (int bj = 0; bj < 2; ++bj) { float uh[8];
#pragma unroll
            for (int e = 0; e < 8; ++e) uh[e] = ri ? 0.f : sgn * __uint_as_float((unsigned)um[(size_t)(bj * 128 + lcol + e) * 4096] << 16);
#pragma unroll
            for (int ai = 0; ai < 2; ++ai)
#pragma unroll
                for (int m = 0; m < 4; ++m) { const f32x4 a0 = acc[ai][bj][m][0], a1 = acc[ai][bj][m][1]; const float sc = 1.0f / 1024.0f;
                    u32x4 w; w.x = cvt_pk_bf16((a0[0] + uh[0]) * sc, (a0[1] + uh[1]) * sc); w.y = cvt_pk_bf16((a0[2] + uh[2]) * sc, (a0[3] + uh[3]) * sc);
                    w.z = cvt_pk_bf16((a1[0] + uh[4]) * sc, (a1[1] + uh[5]) * sc); w.w = cvt_pk_bf16((a1[2] + uh[6]) * sc, (a1[3] + uh[7]) * sc);
                    *(u32x4*)(dst + (size_t)(ai * 128 + m * 16) * 2048 + bj * 128 + lo) = w; } }
    } };

struct SchedMerge { int G, c; __device__ bool next(int i, Unit& u) const { const int t = (i >> 1) * G + c; if (t >= 256) return false; u.kind = i & 1; u.aux = 0; pg8::tile_map(t, 32, 8, u.pm, u.pn); return true; } };
struct ProbMerge { const char *o, *zcat, *wo, *wfp; static constexpr size_t TS = (size_t)256 * 2048 * 2;
    __device__ const char* A(const Unit& u) const { return (u.kind ? zcat : o) + (size_t)u.pm * TS; }
    __device__ const char* B(const Unit& u) const { return (u.kind ? wfp : wo) + (size_t)u.pn * TS; } };
struct EpiMerge { const bf16_t* g; float* t1; bf16_t* t;
    __device__ void operator()(const f32x4 (&acc)[2][2][4][2], const Unit& u, int wr, int wc, int fr, int fq) const {
        asm volatile("" : "+v"(fr), "+v"(fq));
        const unsigned lrow = (unsigned)(wr * 64 + fr), lcol = (unsigned)(wc * 32 + 8 * fq);
        const unsigned lo_g = lrow * 4096u + lcol, lo_t = lrow * 2048u + lcol;
        const bf16_t* gu = g + (size_t)(u.pm * 256) * 4096 + (u.kind ? 2048 : 0) + u.pn * 256;
        float* t1u = t1 + (size_t)(u.pm * 256) * 2048 + u.pn * 256; bf16_t* tu = t + (size_t)(u.pm * 256) * 2048 + u.pn * 256;
#pragma unroll
        for (int ai = 0; ai < 2; ++ai)
#pragma unroll
            for (int m = 0; m < 4; ++m) {
#pragma unroll
                for (int bj = 0; bj < 2; ++bj) { const size_t ro = (size_t)(ai * 128 + m * 16);
                    const u32x4 gw = *(const u32x4*)(gu + ro * 4096 + bj * 128 + lo_g);
                    f32x4 v0 = acc[ai][bj][m][0], v1 = acc[ai][bj][m][1];
                    v0.x *= sigmoidf_(bf_lo(gw.x)); v0.y *= sigmoidf_(bf_hi(gw.x)); v0.z *= sigmoidf_(bf_lo(gw.y)); v0.w *= sigmoidf_(bf_hi(gw.y));
                    v1.x *= sigmoidf_(bf_lo(gw.z)); v1.y *= sigmoidf_(bf_hi(gw.z)); v1.z *= sigmoidf_(bf_lo(gw.w)); v1.w *= sigmoidf_(bf_hi(gw.w));
                    float* tp = t1u + ro * 2048 + bj * 128 + lo_t;
                    if (u.kind == 0) { *(f32x4*)tp = v0; *(f32x4*)(tp + 4) = v1; }
                    else { v0 += *(const f32x4*)tp; v1 += *(const f32x4*)(tp + 4);
                        u32x4 w; w.x = cvt_pk_bf16(v0[0], v0[1]); w.y = cvt_pk_bf16(v0[2], v0[3]); w.z = cvt_pk_bf16(v1[0], v1[1]); w.w = cvt_pk_bf16(v1[2], v1[3]);
                        *(u32x4*)(tu + ro * 2048 + bj * 128 + lo_t) = w; } } }
    } };

struct SchedN8 { int G, c; __device__ bool next(int i, Unit& u) const { const int L = i * G + c; if (L >= 256) return false; u.kind = 0; u.aux = 0; pg8::tile_map(L, 32, 8, u.pm, u.pn); return true; } };
struct ProbPlain { const char* a; const char* b; size_t ts; __device__ const char* A(const Unit& u) const { return a + (size_t)u.pm * ts; } __device__ const char* B(const Unit& u) const { return b + (size_t)u.pn * ts; } };
struct EpiRes { const float* res; float* out; const float* gate;
    __device__ void operator()(const f32x4 (&acc)[2][2][4][2], const Unit& u, int wr, int wc, int fr, int fq) const {
        asm volatile("" : "+v"(fr), "+v"(fq));
        const unsigned lcol = (unsigned)(wc * 32 + 8 * fq), lo = (unsigned)(wr * 64 + fr) * 2048u + lcol;
        const float* gb = gate + (size_t)(u.pm >> 4) * (NMOD * DM) + u.pn * 256;
        const float* ru = res + (size_t)(u.pm * 256) * 2048 + u.pn * 256; float* ou = out + (size_t)(u.pm * 256) * 2048 + u.pn * 256;
#pragma unroll
        for (int bj = 0; bj < 2; ++bj) { const f32x4 g0 = *(const f32x4*)(gb + bj * 128 + lcol), g1 = *(const f32x4*)(gb + bj * 128 + lcol + 4);
#pragma unroll
            for (int ai = 0; ai < 2; ++ai)
#pragma unroll
                for (int m = 0; m < 4; ++m) { const size_t ro = (size_t)(ai * 128 + m * 16) * 2048 + bj * 128;
                    const f32x4 r0 = *(const f32x4*)(ru + ro + lo), r1 = *(const f32x4*)(ru + ro + lo + 4);
                    *(f32x4*)(ou + ro + lo) = r0 + g0 * acc[ai][bj][m][0]; *(f32x4*)(ou + ro + lo + 4) = r1 + g1 * acc[ai][bj][m][1]; } }
    } };

struct SchedUp { int G, c; __device__ bool next(int i, Unit& u) const { const int L = i * G + c; if (L >= 1024) return false; u.kind = 0; u.aux = 0; pg8::tile_map(L, 32, 32, u.pm, u.pn); return true; } };
struct EpiUp { bf16_t* hb;
    __device__ void operator()(const f32x4 (&acc)[2][2][4][2], const Unit& u, int wr, int wc, int fr, int fq) const {
        asm volatile("" : "+v"(fr), "+v"(fq));
        const unsigned lo = (unsigned)(wr * 64 + fr) * (unsigned)DFF + (unsigned)(wc * 32 + 8 * fq);
        bf16_t* hu = hb + (size_t)(u.pm * 256) * DFF + u.pn * 256;
#pragma unroll
        for (int ai = 0; ai < 2; ++ai)
#pragma unroll
            for (int m = 0; m < 4; ++m) {
#pragma unroll
                for (int bj = 0; bj < 2; ++bj) { f32x4 v0 = acc[ai][bj][m][0], v1 = acc[ai][bj][m][1];
                    v0.x = fmaxf(v0.x, 0.f); v0.y = fmaxf(v0.y, 0.f); v0.z = fmaxf(v0.z, 0.f); v0.w = fmaxf(v0.w, 0.f); v1.x = fmaxf(v1.x, 0.f); v1.y = fmaxf(v1.y, 0.f); v1.z = fmaxf(v1.z, 0.f); v1.w = fmaxf(v1.w, 0.f);
                    v0 = v0 * v0; v1 = v1 * v1;
                    u32x4 w; w.x = cvt_pk_bf16(v0[0], v0[1]); w.y = cvt_pk_bf16(v0[2], v0[3]); w.z = cvt_pk_bf16(v1[0], v1[1]); w.w = cvt_pk_bf16(v1[2], v1[3]);
                    *(u32x4*)(hu + (size_t)(ai * 128 + m * 16) * DFF + bj * 128 + lo) = w; } }
    } };

constexpr int N_PHASES = 11;

template <bool COOP>
__global__ void __launch_bounds__(512, 2) fwd_kernel(Args args) {
    extern __shared__ __attribute__((aligned(16))) unsigned char lds_raw[];
    Frame F;
    F.lds = (LAS unsigned char*)lds_raw;
    F.wave = __builtin_amdgcn_readfirstlane(threadIdx.x >> 6);
    F.G = gridDim.x; F.bid = blockIdx.x;
    unsigned char* ws = args.ws;
    const int lo = args.ph_lo, hi = args.ph_hi;
    const int gw = F.bid * 8 + F.wave, NGW = F.G * 8;
    const int NGT = F.G * 512;
#define PHASE_IDS() const int lane_ = lane_now(), tid_ = F.wave * 64 + lane_, gt = F.bid * 512 + tid_; (void)gt

    float* mod = (float*)(ws + WS_MOD);
    bf16_t* csd = (bf16_t*)(ws + WS_CSD); bf16_t* kcraw = (bf16_t*)(ws + WS_KCRAW);
    bf16_t* winT = (bf16_t*)(ws + WS_WIN); bf16_t* woT = (bf16_t*)(ws + WS_WO); bf16_t* wfg = (bf16_t*)(ws + WS_WFG); bf16_t* woutT = (bf16_t*)(ws + WS_WOUT);
    bf16_t* wfpT = (bf16_t*)(ws + WS_WFP); bf16_t* csn = (bf16_t*)(ws + WS_CSN); bf16_t* w1T = (bf16_t*)(ws + WS_W1); bf16_t* w2T = (bf16_t*)(ws + WS_W2);
    bf16_t* xn = (bf16_t*)(ws + WS_XN); bf16_t* gbuf = (bf16_t*)(ws + WS_G); bf16_t* qb = (bf16_t*)(ws + WS_Q); bf16_t* ob = (bf16_t*)(ws + WS_O);
    bf16_t* hb = (bf16_t*)(ws + WS_HB); bf16_t* kraw = (bf16_t*)(ws + WS_KRAW); bf16_t* kall = (bf16_t*)(ws + WS_KALL); bf16_t* vall = (bf16_t*)(ws + WS_VALL); bf16_t* ut = (bf16_t*)(ws + WS_UT);
    bf16_t* zcat = xn; bf16_t* tb = qb; float* t1 = args.out; bf16_t* et = (bf16_t*)(ws + WS_ET); bf16_t* ot = (bf16_t*)(ws + WS_OT);

#define IN(k) (lo <= (k) && (k) < hi)
#define SEAM(k) do { if (COOP) { if (IN(k) && IN((k) + 1)) { xcd_barrier(bar, F.wave); } } } while (0)
#define REP(k) for (int rep_ = 0; rep_ < ((PROBE_REP == (k)) ? 2 : 1); ++rep_)

    volatile LAS unsigned* MISC = (volatile LAS unsigned*)(F.lds + 131072);
    { PHASE_IDS(); if (tid_ < 64) MISC[tid_] = 0u;
    if (COOP && F.bid == 0) { unsigned* bw = (unsigned*)(ws + WS_BAR); for (int i = tid_; i < XCD_BAR_WORDS; i += 512) bw[i] = 0u; } }
    __syncthreads();
    REP(0) if (IN(0)) { PHASE_IDS();
        {
            LAS float* sv = (LAS float*)(F.lds + 69632);
            LAS float* red = (LAS float*)(F.lds + 94208);
            for (int i = tid_; i < 3 * DM; i += 512) { const float v = (i < 2 * DM) ? args.in[I_C][i] : args.in[I_CCTX][i - 2 * DM]; sv[i] = v / (1.0f + __expf(-v)); }
            __syncthreads();
            const float* wada = args.in[I_WADA];
            for (int cgp = F.bid; cgp < 256; cgp += F.G) {
                const int col = cgp * 48 + (lane_ < 48 ? lane_ : 47);
                float a0 = 0.f, a1 = 0.f, a2 = 0.f;
                const int kb = F.wave * 256;
#pragma unroll 16
                for (int k = 0; k < 256; ++k) { const float w = wada[(size_t)(kb + k) * (NMOD * DM) + col]; a0 += sv[kb + k] * w; a1 += sv[DM + kb + k] * w; a2 += sv[2 * DM + kb + k] * w; }
                if (lane_ < 48) { red[(F.wave * 3 + 0) * 48 + lane_] = a0; red[(F.wave * 3 + 1) * 48 + lane_] = a1; red[(F.wave * 3 + 2) * 48 + lane_] = a2; }
                __syncthreads();
                if (tid_ < 144) { const int j = tid_ / 48, l = tid_ % 48; float s = 0.f;
#pragma unroll
                    for (int w = 0; w < 8; ++w) s += red[(w * 3 + j) * 48 + l];
                    mod[j * (NMOD * DM) + cgp * 48 + l] = s + args.in[I_BADA][cgp * 48 + l]; }
                __syncthreads();
            }
        }
        {
            LAS float* scr = (LAS float*)(F.lds + F.wave * 8448);
            constexpr int I_IN = 32 * 256;
            for (int r = gw; r < I_IN; r += NGW) { const int kb = r >> 8, nb = r & 255, n0 = nb * 32; const int drow = n0 < 3072 ? n0 : (n0 < 4096 ? n0 + 4096 : n0 - 1024);
                transpose_item(args.in[I_WIN], INW, kb * 64, n0, winT + (size_t)drow * DM + kb * 64, DM, scr, lane_); }
        }
        for (int it = gt; it < 512 * 32; it += NGT) { const int R = it >> 5, n0 = (it & 31) * 8, k = R & 255, ri = R >> 8;
            unsigned w[4];
#pragma unroll
            for (int e = 0; e < 4; ++e) { float v[2];
#pragma unroll
                for (int h = 0; h < 2; ++h) { const int mm = (k * (n0 + 2 * e + h)) & 255; const float rev = (float)mm * (1.0f / 256.0f); v[h] = ri ? __builtin_amdgcn_sinf(rev) : __builtin_amdgcn_cosf(rev); }
                w[e] = cvt_pk_bf16(v[0], v[1]); }
            *(u32x4*)(csd + (size_t)R * 256 + n0) = (u32x4){w[0], w[1], w[2], w[3]}; }
        __syncthreads();
    }
    XcdBarrier bar; bar.bar = (unsigned*)(ws + WS_BAR); bar.x = 0; bar.st = MISC + 8;
    if (COOP) { cg::this_grid().sync();
        bar = xcd_barrier_post((unsigned*)(ws + WS_BAR), MISC + 8, F.wave); }

    REP(1) if (IN(1)) { PHASE_IDS();
        {
            for (int it = gw; it < 2048 + 128; it += NGW) {
                if (it < 2048) { const int r0 = it * 4, b = r0 / SEQ; const float* mb = mod + (size_t)b * (NMOD * DM);
                    norm_mod_rows(args.in[I_X], xn, args.in[I_N1G], mb + DM, mb, r0, 4, lane_); }
                else { const int r0 = (it - 2048) * 4; const float* mb = mod + (size_t)2 * (NMOD * DM);
                    norm_mod_rows(args.in[I_CTX], xn + (size_t)MTOK * DM, args.in[I_N1G], mb + DM, mb, r0, 4, lane_); }
            }
        }
        __syncthreads();
    }
    if (COOP) for (int xb_ = 0; xb_ < PROBE_BARS; ++xb_) xcd_barrier(bar, F.wave);
    SEAM(1);

    REP(2) if (IN(2)) {
        SchedIn S{F.G, F.bid}; ProbIn P{(const char*)xn, (const char*)winT}; EpiIn E{qb, kraw, kcraw, vall, gbuf, ut};
        pg8::gemm_phase<EpiIn, SchedIn, ProbIn>(F.lds, F.wave, 2048, S, P, E);
        { PHASE_IDS(); const int nfull = 1032 % F.G;
          if (F.bid >= nfull) { const int cid = F.bid - nfull, ncv = F.G - nfull;
            LAS float* scr = (LAS float*)(F.lds + F.wave * 8448);
            constexpr int I_1 = 32 * 256, I_2 = 128 * 64, I_AO = 32 * 64, I_FO = 16 * 64, I_OUT = 32 * 64, NIT = I_1 + I_2 + I_AO + I_FO + I_OUT;
            for (int it = cid * 8 + F.wave; it < NIT; it += ncv * 8) {
                int r = it;
                if (r < I_1) { const int kb = r >> 8, nb = r & 255; transpose_item(args.in[I_W1], DFF, kb * 64, nb * 32, w1T + (size_t)(nb * 32) * DM + kb * 64, DM, scr, lane_); continue; } r -= I_1;
                if (r < I_2) { const int kb = r >> 6, nb = r & 63; transpose_item(args.in[I_W2], DM, kb * 64, nb * 32, w2T + (size_t)(nb * 32) * DFF + kb * 64, DFF, scr, lane_); continue; } r -= I_2;
                if (r < I_AO) { const int kb = r >> 6, nb = r & 63; transpose_item(args.in[I_WAO], DM, kb * 64, nb * 32, woT + (size_t)(nb * 32) * DM + kb * 64, DM, scr, lane_); continue; } r -= I_AO;
                if (r < I_FO) { const int kb = r >> 6, nb = r & 63, k0 = kb * 64, g = k0 >> 8; transpose_item(args.in[I_WF], DM, k0, nb * 32, wfg + ((size_t)g * 2048 + nb * 32) * 256 + (k0 & 255), 256, scr, lane_); continue; } r -= I_FO;
                { const int kb = r >> 6, nb = r & 63; transpose_item(args.in[I_WOUT], DM, kb * 64, nb * 32, woutT + (size_t)(nb * 32) * DM + kb * 64, DM, scr, lane_); }
            }
            for (int it = cid * 512 + tid_; it < 8192 * 256; it += ncv * 512) { const int R = it >> 8, n0 = (it & 255) * 8, k = R & 4095, ri = R >> 12;
                unsigned w[4];
#pragma unroll
                for (int e = 0; e < 4; ++e) { float v[2];
#pragma unroll
                    for (int h = 0; h < 2; ++h) { const int mm = (k * (n0 + 2 * e + h)) & 4095; const float rev = (float)mm * (1.0f / 4096.0f); v[h] = ri ? -__builtin_amdgcn_sinf(rev) : __builtin_amdgcn_cosf(rev); }
                    w[e] = cvt_pk_bf16(v[0], v[1]); }
                *(u32x4*)(csn + (size_t)R * 2048 + n0) = (u32x4){w[0], w[1], w[2], w[3]}; }
          }
          __syncthreads(); }
    }
    SEAM(2);

    if (IN(3)) { PHASE_IDS();
        LAS f32x2* tab = (LAS f32x2*)F.lds;
        for (int i = tid_; i < 2048; i += 512) { const int idx = i >> 5, j = i & 31; const float inv = __builtin_amdgcn_exp2f(-(float)j * (13.287712379549449f / 32.0f));
            const float ang = (float)idx * inv, rev = ang * 0.15915494309189535f; tab[i] = (f32x2){__builtin_amdgcn_cosf(rev), __builtin_amdgcn_sinf(rev)}; }
        __syncthreads();
        const int l16 = lane_ & 15, sub = lane_ >> 4;
        const f32x4 gq0 = *(const f32x4*)(args.in[I_QNG] + 8 * l16), gq1 = *(const f32x4*)(args.in[I_QNG] + 8 * l16 + 4);
        const f32x4 gk0 = *(const f32x4*)(args.in[I_KNG] + 8 * l16), gk1 = *(const f32x4*)(args.in[I_KNG] + 8 * l16 + 4);
        constexpr int NRQ = MTOK * NQH, NRK = MTOK * NKVH, NRC = NCTX * NKVH, NITEMS = (NRQ + NRK + NRC) / 4;
        for (int it = gw; it < NITEMS; it += NGW) {
            int row = it * 4 + sub; const bf16_t* src; bf16_t* dst; int pos = -1; bool isq = false;
            if (row < NRQ) { const int t = row >> 4, h = row & 15; src = qb + (size_t)t * DM + h * HD; dst = qb + (size_t)t * DM + h * HD; pos = t & (SEQ - 1); isq = true; }
            else if (row < NRQ + NRK) { row -= NRQ; const int t = row >> 2, h = row & 3; src = kraw + (size_t)t * KVW + h * HD; dst = kall + (size_t)(t + (t / SEQ) * CTXL) * KVW + h * HD; pos = t & (SEQ - 1); }
            else { row -= NRQ + NRK; const int t = row >> 2, h = row & 3; src = kcraw + (size_t)t * KVW + h * HD; dst = kall + (size_t)((t / CTXL) * SKV + SEQ + (t % CTXL)) * KVW + h * HD; }
            const u32x4 raw = *(const u32x4*)(src + 8 * l16);
            float v[8] = {bf_lo(raw.x), bf_hi(raw.x), bf_lo(raw.y), bf_hi(raw.y), bf_lo(raw.z), bf_hi(raw.z), bf_lo(raw.w), bf_hi(raw.w)};
            float ss = 0.f;
#pragma unroll
            for (int e = 0; e < 8; ++e) ss += v[e] * v[e];
            ss += __shfl_xor(ss, 1); ss += __shfl_xor(ss, 2); ss += __shfl_xor(ss, 4); ss += __shfl_xor(ss, 8);
            const float rstd = 1.0f / sqrtf(ss * (1.0f / HD) + EPS);
            const f32x4 g0 = isq ? gq0 : gk0, g1 = isq ? gq1 : gk1;
            v[0] *= rstd * g0.x; v[1] *= rstd * g0.y; v[2] *= rstd * g0.z; v[3] *= rstd * g0.w; v[4] *= rstd * g1.x; v[5] *= rstd * g1.y; v[6] *= rstd * g1.z; v[7] *= rstd * g1.w;
            if (pos >= 0) { const int idx = (l16 < 8) ? (pos >> 6) : (pos & 63); const int j0 = (4 * l16) & 31;
#pragma unroll
                for (int e = 0; e < 4; ++e) { const f32x2 cs = tab[idx * 32 + j0 + e]; const float x1 = v[2 * e], x2 = v[2 * e + 1]; v[2 * e] = x1 * cs.x - x2 * cs.y; v[2 * e + 1] = x1 * cs.y + x2 * cs.x; } }
            u32x4 w; w.x = cvt_pk_bf16(v[0], v[1]); w.y = cvt_pk_bf16(v[2], v[3]); w.z = cvt_pk_bf16(v[4], v[5]); w.w = cvt_pk_bf16(v[6], v[7]);
            *(u32x4*)(dst + 8 * l16) = w;
        }
        for (int row = gw; row < NB * FW; row += NGW) {
            const bf16_t* ur = ut + (size_t)row * SEQ; bf16_t* er = et + (size_t)row * 2048; bf16_t* orow = ot + (size_t)row * 2048;
#pragma unroll
            for (int j = 0; j < 4; ++j) { const int n0 = 8 * (lane_ + 64 * j);
                const u32x4 a = *(const u32x4*)(ur + n0), bq = *(const u32x4*)(ur + SEQ - n0 - 8);
                const float f0 = n0 ? __uint_as_float((unsigned)ur[SEQ - n0] << 16) : 0.f;
                const float av[8] = {bf_lo(a.x), bf_hi(a.x), bf_lo(a.y), bf_hi(a.y), bf_lo(a.z), bf_hi(a.z), bf_lo(a.w), bf_hi(a.w)};
                const float bv[8] = {f0, bf_hi(bq.w), bf_lo(bq.w), bf_hi(bq.z), bf_lo(bq.z), bf_hi(bq.y), bf_lo(bq.y), bf_hi(bq.x)};
                float ev[8], ov[8];
#pragma unroll
                for (int e = 0; e < 8; ++e) { ev[e] = av[e] + bv[e]; ov[e] = av[e] - bv[e]; }
                if (n0 == 0) ov[0] = 0.f;
                u32x4 we, wo; we.x = cvt_pk_bf16(ev[0], ev[1]); we.y = cvt_pk_bf16(ev[2], ev[3]); we.z = cvt_pk_bf16(ev[4], ev[5]); we.w = cvt_pk_bf16(ev[6], ev[7]);
                wo.x = cvt_pk_bf16(ov[0], ov[1]); wo.y = cvt_pk_bf16(ov[2], ov[3]); wo.z = cvt_pk_bf16(ov[4], ov[5]); wo.w = cvt_pk_bf16(ov[6], ov[7]);
                *(u32x4*)(er + n0) = we; *(u32x4*)(orow + n0) = wo; }
        }
        __syncthreads();
        { SchedWfp S{F.G, F.bid}; ProbWfp P{(const char*)wfg, (const char*)csd}; EpiWfp E{wfpT};
          pg8::gemm_phase<EpiWfp, SchedWfp, ProbWfp>(F.lds, F.wave, 256, S, P, E); }
    }
    SEAM(3);

    REP(4) if (IN(4)) {
        {
            const bool x8 = (F.G % 8) == 0; const int per = x8 ? F.G / 8 : F.G;
            for (int i = 0;; ++i) {
                int u;
                if (x8) { const int xcd = F.bid & 7, j = F.bid >> 3, idx = i * per + j; if (idx >= 64) break; u = xcd * 64 + idx; }
                else { u = i * F.G + F.bid; if (u >= 512) break; }
                const int bk = u >> 6, idx = u & 63, b = bk >> 2, kvh = bk & 3, h = kvh * 4 + (idx >> 4), qblk = idx & 15;
                const att::bf16* Qp = (const att::bf16*)qb + (size_t)(b * SEQ + qblk * 256) * DM + h * HD;
                const att::bf16* Kp = (const att::bf16*)kall + (size_t)(b * SKV) * KVW + kvh * HD;
                const att::bf16* Vp = (const att::bf16*)vall + (size_t)(b * SKV) * KVW + kvh * HD;
                att::bf16* Op = (att::bf16*)ob + (size_t)(b * SEQ + qblk * 256) * DM + h * HD;
                att::attn_dense_body(Qp, Kp, Vp, Op, SKV, (char*)lds_raw, F.wave);
            }
        }
        __syncthreads();
        { SchedDft S{F.G, F.bid}; ProbDft P{(const char*)csn, (const char*)et, (const char*)ot}; EpiDft E{zcat, ut};
          pg8::gemm_phase<EpiDft, SchedDft, ProbDft>(F.lds, F.wave, 2048, S, P, E); }
    }
    SEAM(4);

    REP(5) if (IN(5)) {
        SchedMerge S{F.G, F.bid}; ProbMerge P{(const char*)ob, (const char*)zcat, (const char*)woT, (const char*)wfpT}; EpiMerge E{gbuf, t1, tb};
        pg8::gemm_phase<EpiMerge, SchedMerge, ProbMerge>(F.lds, F.wave, 2048, S, P, E);
    }
    SEAM(5);

    REP(6) if (IN(6)) {
        SchedN8 S{F.G, F.bid}; ProbPlain P{(const char*)tb, (const char*)woutT, (size_t)256 * 2048 * 2}; EpiRes E{args.in[I_X], args.out, mod + 2 * DM};
        pg8::gemm_phase<EpiRes, SchedN8, ProbPlain>(F.lds, F.wave, 2048, S, P, E);
    }
    SEAM(6);

    REP(7) if (IN(7)) { PHASE_IDS();
        for (int it = gw; it < 2048; it += NGW) { const int r0 = it * 4, b = r0 / SEQ; const float* mb = mod + (size_t)b * (NMOD * DM);
            norm_mod_rows(args.out, xn, args.in[I_N2G], mb + 4 * DM, mb + 3 * DM, r0, 4, lane_); }
        __syncthreads();
    }
    SEAM(7);

    REP(8) if (IN(8)) {
        SchedUp S{F.G, F.bid}; ProbPlain P{(const char*)xn, (const char*)w1T, (size_t)256 * 2048 * 2}; EpiUp E{hb};
        pg8::gemm_phase<EpiUp, SchedUp, ProbPlain>(F.lds, F.wave, 2048, S, P, E);
    }
    SEAM(8);

    if (IN(9)) {
        SchedN8 S{F.G, F.bid}; ProbPlain P{(const char*)hb, (const char*)w2T, (size_t)256 * 8192 * 2}; EpiRes E{args.out, args.out, mod + 5 * DM};
        pg8::gemm_phase<EpiRes, SchedN8, ProbPlain>(F.lds, F.wave, 8192, S, P, E);
    }
    SEAM(9);

    if (IN(10)) { PHASE_IDS();
        const float* fg = args.in[I_FNG];
        f32x4 A[8];
#pragma unroll
        for (int j = 0; j < 8; ++j) A[j] = *(const f32x4*)(fg + 4 * lane_ + 256 * j);
        for (int r = gw; r < MTOK; r += NGW) {
            f32x4* xr = (f32x4*)(args.out + (size_t)r * DM) + lane_;
            f32x4 v[8]; float ss = 0.f;
#pragma unroll
            for (int j = 0; j < 8; ++j) { v[j] = xr[64 * j]; ss += (v[j].x * v[j].x + v[j].y * v[j].y) + (v[j].z * v[j].z + v[j].w * v[j].w); }
            const float rstd = 1.0f / sqrtf(wave_sum(ss) * (1.0f / DM) + EPS);
#pragma unroll
            for (int j = 0; j < 8; ++j) xr[64 * j] = v[j] * rstd * A[j];
        }
    }
#undef IN
#undef SEAM
}

extern "C" void kernel_launch(void* const* d_in, const int* in_sizes, int n_in, void* d_out, int out_size, void* d_ws, size_t ws_size, hipStream_t stream) {
    static int grid = 0;
    if (grid == 0) {
        if (n_in != 17 || in_sizes[0] != MTOK * DM || out_size != MTOK * DM || ws_size < WS_END) {
            fprintf(stderr, "kernel_launch: shape/workspace mismatch: n_in %d in0 %d out %d ws %zu (need %zu)\n", n_in, n_in > 0 ? in_sizes[0] : -1, out_size, ws_size, (size_t)WS_END); grid = -1; return; }
        int dev = 0, cus = 0, per_cu = 0;
        hipGetDevice(&dev); hipDeviceGetAttribute(&cus, hipDeviceAttributeMultiprocessorCount, dev);
        if (hipFuncSetAttribute((const void*)fwd_kernel<true>, hipFuncAttributeMaxDynamicSharedMemorySize, LDS_BYTES) != hipSuccess) fprintf(stderr, "kernel_launch: hipFuncSetAttribute(coop) failed\n");
        if (hipFuncSetAttribute((const void*)fwd_kernel<false>, hipFuncAttributeMaxDynamicSharedMemorySize, LDS_BYTES) != hipSuccess) fprintf(stderr, "kernel_launch: hipFuncSetAttribute(plain) failed\n");
        if (hipOccupancyMaxActiveBlocksPerMultiprocessor(&per_cu, (const void*)fwd_kernel<true>, 512, LDS_BYTES) != hipSuccess || per_cu < 1) { fprintf(stderr, "kernel_launch: occupancy query says %d blocks per CU\n", per_cu); per_cu = 1; }
        (void)hipGetLastError();
        grid = cus;
        fprintf(stderr, "kernel_launch: grid %d (cus %d, per_cu %d)\n", grid, cus, per_cu);
    }
    if (grid < 0) return;
    Args a{};
    for (int i = 0; i < 17; ++i) a.in[i] = (const float*)d_in[i];
    a.out = (float*)d_out; a.ws = (unsigned char*)d_ws;
#if MK_COOP
    a.ph_lo = 0; a.ph_hi = N_PHASES;
    void* kargs[] = {&a};
    hipError_t e = hipLaunchCooperativeKernel((const void*)fwd_kernel<true>, dim3(grid), dim3(512), kargs, LDS_BYTES, stream);
    if (e != hipSuccess) fprintf(stderr, "kernel_launch: cooperative launch failed: %s (grid %d)\n", hipGetErrorString(e), grid);
#else
    for (int p = 0; p < N_PHASES; ++p) { a.ph_lo = p; a.ph_hi = p + 1; hipLaunchKernelGGL(fwd_kernel<false>, dim3(grid), dim3(512), LDS_BYTES, stream, a); }
    const hipError_t le = hipPeekAtLastError();
    if (le != hipSuccess) fprintf(stderr, "kernel_launch: launch failed: %s\n", hipGetErrorName(le));
#endif
}
```
